# Optimizing an MI355X kernel written in HIP

```python
import jax, jax.numpy as jnp
from jax import lax
import numpy as np

D_MODEL = 1024
BATCH = 16
SEQ = 4096
DEPTH = 4

HEAD_DIM = 64
ROPE_THETA = 500000.0
ROT_DIM = HEAD_DIM // 4
NORM_EPS = 1e-6
NEG_INF = -1e30
D_FF = 4 * D_MODEL

A_WIDTH = D_MODEL // 2
A_HEADS = A_WIDTH // HEAD_DIM
A_KV_HEADS = A_HEADS // 4
A_GROUP = A_HEADS // A_KV_HEADS
A_KV_WIDTH = A_KV_HEADS * HEAD_DIM
A_RADIUS = 128
POOL_WIDTH = D_MODEL - A_WIDTH
POOL_WINDOWS = (2, 4, 8, 16)
POOL_GROUPS = len(POOL_WINDOWS)
POOL_GROUP_WIDTH = POOL_WIDTH // POOL_GROUPS
EVEN_IN = A_WIDTH + 2 * A_KV_WIDTH + POOL_WIDTH
EVEN_MIX = A_WIDTH + POOL_WIDTH

C_PATTERNS = ((128, 1), (512, 4), (2048, 16))
N_C_GROUPS = len(C_PATTERNS)
C_HEADS_PER_GROUP = D_MODEL // (2 * HEAD_DIM)
C_KV_HEADS = C_HEADS_PER_GROUP // 2
C_GROUP = C_HEADS_PER_GROUP // C_KV_HEADS
C_Q_WIDTH = N_C_GROUPS * C_HEADS_PER_GROUP * HEAD_DIM
C_KV_WIDTH = C_KV_HEADS * HEAD_DIM
ODD_IN = C_Q_WIDTH + 2 * C_KV_WIDTH
C_MIX = C_HEADS_PER_GROUP * HEAD_DIM

N_EVEN = (DEPTH + 1) // 2
N_ODD = DEPTH // 2

kernel_name = "hybrid_bidir_swa_pool_dilated"


def rms_norm(x, g):
    xf = x.astype(jnp.float32)
    y = xf * lax.rsqrt(jnp.mean(xf * xf, axis=-1, keepdims=True) + NORM_EPS)
    return (y * g.astype(jnp.float32)).astype(x.dtype)


def rope_tables(seq_len):
    pos = jnp.arange(seq_len, dtype=jnp.float32)
    inv = ROPE_THETA ** (-jnp.arange(0, ROT_DIM, 2, dtype=jnp.float32) / ROT_DIM)
    ang = pos[:, None] * inv[None, :]
    return jnp.cos(ang), jnp.sin(ang)


def apply_partial_rope(x, cos, sin):
    half = ROT_DIM // 2
    xr = x[..., :ROT_DIM].astype(jnp.float32)
    x1, x2 = xr[..., :half], xr[..., half:]
    c, s = cos[None, :, None, :], sin[None, :, None, :]
    rot = jnp.concatenate([x1 * c - x2 * s, x2 * c + x1 * s], axis=-1).astype(x.dtype)
    return jnp.concatenate([rot, x[..., ROT_DIM:]], axis=-1)


def banded_attention(q, k, v, radius, sink=None):
    n, length, kvh, grp, hd = q.shape
    blk = radius
    nb = -(-length // blk)
    pad = nb * blk - length
    qb = jnp.pad(q, ((0, 0), (0, pad), (0, 0), (0, 0), (0, 0))).reshape(n, nb, blk, kvh, grp, hd)
    kv_pad = ((0, 0), (blk, blk + pad), (0, 0), (0, 0))
    kb = jnp.pad(k, kv_pad).reshape(n, nb + 2, blk, kvh, hd)
    vb = jnp.pad(v, kv_pad).reshape(n, nb + 2, blk, kvh, hd)
    kw = jnp.concatenate([kb[:, :-2], kb[:, 1:-1], kb[:, 2:]], axis=2)
    vw = jnp.concatenate([vb[:, :-2], vb[:, 1:-1], vb[:, 2:]], axis=2)
    s = jnp.einsum('nbqhgd,nbkhd->nbhgqk', qb, kw,
                   preferred_element_type=jnp.float32) * (hd ** -0.5)
    q_pos = jnp.arange(nb * blk).reshape(nb, blk)
    k_pos = jnp.arange(nb)[:, None] * blk - blk + jnp.arange(3 * blk)[None, :]
    kp = k_pos[:, None, :]
    valid = (jnp.abs(q_pos[:, :, None] - kp) <= radius) & (kp >= 0) & (kp < length)
    s = jnp.where(valid[None, :, None, None], s, NEG_INF)
    m = jnp.max(s, axis=-1)
    if sink is not None:
        sk = sink.astype(jnp.float32)[None, None, :, :, None]
        m = jnp.maximum(m, sk)
    p = jnp.exp(s - m[..., None])
    denom = jnp.sum(p, axis=-1)
    if sink is not None:
        denom = denom + jnp.exp(sk - m)
    o = jnp.einsum('nbhgqk,nbkhd->nbhgqd', p, vw.astype(jnp.float32)) / denom[..., None]
    lse = m + jnp.log(denom)
    o = o.transpose(0, 1, 4, 2, 3, 5).reshape(n, nb * blk, kvh, grp, hd)[:, :length]
    lse = lse.transpose(0, 1, 4, 2, 3).reshape(n, nb * blk, kvh, grp)[:, :length]
    return o.astype(q.dtype), lse


def pool_mixer(p, w_pool, scale):
    b, s, _ = p.shape
    pf = p.astype(jnp.float32)
    cs = jnp.pad(jnp.cumsum(pf, axis=1), ((0, 0), (1, 0), (0, 0)))
    t = jnp.arange(s)
    outs = []
    for g, w in enumerate(POOL_WINDOWS):
        lo = jnp.clip(t - w // 2, 0, s)
        hi = jnp.clip(t + w // 2, 0, s)
        sl = slice(g * POOL_GROUP_WIDTH, (g + 1) * POOL_GROUP_WIDTH)
        csg = cs[:, :, sl]
        mean = (csg[:, hi] - csg[:, lo]) / (hi - lo).astype(jnp.float32)[None, :, None]
        outs.append(jnp.einsum('bsc,cd->bsd', (mean - pf[..., sl]).astype(p.dtype), w_pool[g]))
    return jnp.concatenate(outs, axis=-1) * scale


def even_mixer(h, w_in, w_out, sink, w_pool, pool_scale, cos, sin):
    b, s, _ = h.shape
    proj = h @ w_in
    q, k, v, p = jnp.split(proj, [A_WIDTH, A_WIDTH + A_KV_WIDTH, A_WIDTH + 2 * A_KV_WIDTH], axis=-1)
    q = apply_partial_rope(q.reshape(b, s, A_HEADS, HEAD_DIM), cos, sin)
    k = apply_partial_rope(k.reshape(b, s, A_KV_HEADS, HEAD_DIM), cos, sin)
    v = v.reshape(b, s, A_KV_HEADS, HEAD_DIM)
    q = q.reshape(b, s, A_KV_HEADS, A_GROUP, HEAD_DIM)
    attn, _ = banded_attention(q, k, v, A_RADIUS, sink.reshape(A_KV_HEADS, A_GROUP))
    pool = pool_mixer(p, w_pool, pool_scale)
    return jnp.concatenate([attn.reshape(b, s, A_WIDTH), pool], axis=-1) @ w_out


def to_strided(x, d):
    b, s = x.shape[:2]
    rest = x.shape[2:]
    x = jnp.moveaxis(x.reshape(b, s // d, d, *rest), 2, 1)
    return x.reshape(b * d, s // d, *rest)


def from_strided(x, b, d):
    n, l = x.shape[:2]
    rest = x.shape[2:]
    x = jnp.moveaxis(x.reshape(b, d, l, *rest), 1, 2)
    return x.reshape(b, l * d, *rest)


def odd_mixer(h, w_in, w_out, cos, sin):
    b, s, _ = h.shape
    proj = h @ w_in
    q, k, v = jnp.split(proj, [C_Q_WIDTH, C_Q_WIDTH + C_KV_WIDTH], axis=-1)
    q = apply_partial_rope(q.reshape(b, s, N_C_GROUPS * C_HEADS_PER_GROUP, HEAD_DIM), cos, sin)
    q = q.reshape(b, s, N_C_GROUPS, C_KV_HEADS, C_GROUP, HEAD_DIM)
    k = apply_partial_rope(k.reshape(b, s, C_KV_HEADS, HEAD_DIM), cos, sin)
    v = v.reshape(b, s, C_KV_HEADS, HEAD_DIM)
    outs, lses = [], []
    for g, (window, dil) in enumerate(C_PATTERNS):
        radius = window // (2 * dil)
        o, lse = banded_attention(to_strided(q[:, :, g], dil), to_strided(k, dil),
                                  to_strided(v, dil), radius)
        outs.append(from_strided(o, b, dil))
        lses.append(from_strided(lse, b, dil))
    o = jnp.stack(outs, axis=0)
    wts = jax.nn.softmax(jnp.stack(lses, axis=0), axis=0)
    mixed = jnp.sum(wts[..., None] * o.astype(jnp.float32), axis=0).astype(h.dtype)
    return mixed.reshape(b, s, C_MIX) @ w_out


def setup_inputs(seed: int = 0) -> dict:
    key = jax.random.key(seed)
    ks = jax.random.split(key, 14)
    nrm = jax.random.normal
    f32 = jnp.float32
    return {
        "x": nrm(ks[0], (BATCH, SEQ, D_MODEL), f32),
        "norm_mix": 1.0 + 0.02 * nrm(ks[1], (DEPTH, D_MODEL), f32),
        "norm_mlp": 1.0 + 0.02 * nrm(ks[2], (DEPTH, D_MODEL), f32),
        "norm_final": 1.0 + 0.02 * nrm(ks[3], (D_MODEL,), f32),
        "w_in_even": nrm(ks[4], (N_EVEN, D_MODEL, EVEN_IN), f32) * D_MODEL ** -0.5,
        "w_out_even": nrm(ks[5], (N_EVEN, EVEN_MIX, D_MODEL), f32) * EVEN_MIX ** -0.5,
        "sink_logits": 0.5 * nrm(ks[6], (N_EVEN, A_HEADS), f32),
        "w_pool": nrm(ks[7], (N_EVEN, POOL_GROUPS, POOL_GROUP_WIDTH, POOL_GROUP_WIDTH), f32) * POOL_GROUP_WIDTH ** -0.5,
        "pool_scale": 1.0 + 0.1 * nrm(ks[8], (N_EVEN, POOL_WIDTH), f32),
        "w_in_odd": nrm(ks[9], (N_ODD, D_MODEL, ODD_IN), f32) * D_MODEL ** -0.5,
        "w_out_odd": nrm(ks[10], (N_ODD, C_MIX, D_MODEL), f32) * C_MIX ** -0.5,
        "w_up": nrm(ks[11], (DEPTH, D_MODEL, D_FF), f32) * D_MODEL ** -0.5,
        "w_down": nrm(ks[12], (DEPTH, D_FF, D_MODEL), f32) * D_FF ** -0.5,
    }


def reference(x, norm_mix, norm_mlp, norm_final, w_in_even, w_out_even, sink_logits,
              w_pool, pool_scale, w_in_odd, w_out_odd, w_up, w_down):
    cos, sin = rope_tables(x.shape[1])
    for layer in range(DEPTH):
        i = layer // 2
        h = rms_norm(x, norm_mix[layer])
        if layer % 2 == 0:
            mix = even_mixer(h, w_in_even[i], w_out_even[i], sink_logits[i],
                             w_pool[i], pool_scale[i], cos, sin)
        else:
            mix = odd_mixer(h, w_in_odd[i], w_out_odd[i], cos, sin)
        x = x + mix
        h = rms_norm(x, norm_mlp[layer])
        x = x + jnp.square(jax.nn.relu(h @ w_up[layer])) @ w_down[layer]
    return rms_norm(x, norm_final)
```

```cpp
#include <hip/hip_runtime.h>
#include <hip/hip_cooperative_groups.h>
#include <cstdio>
#include <cstdint>
namespace cg = cooperative_groups;
namespace pg8 {
#define PG8_LAS __attribute__((address_space(3)))
typedef unsigned short bf16_t;
typedef short bf16x8 __attribute__((ext_vector_type(8)));
typedef float f32x4 __attribute__((ext_vector_type(4)));
typedef unsigned u32x4 __attribute__((ext_vector_type(4)));
constexpr int BM = 256, BK = 64, HALF = 128, HTB = HALF * BK * 2  , STAGE_BYTES = 8 * HTB, NXCD = 8, WGM = 8;

__host__ __device__ __forceinline__ int lds_byte(int r, int c) { const int st = (r >> 4) * 2 + (c >> 5), rr = r & 15, cc = c & 31, ob = rr * 64 + cc * 2; return st * 1024 + (ob ^ (((ob >> 9) & 1) << 5)); }
__host__ __device__ __forceinline__ void stage_rc(int b, int& R, int& C) { const int st = b / 1024, sb = b % 1024, swz = sb ^ (((sb >> 9) & 1) << 5); R = (st >> 1) * 16 + swz / 64; C = (st & 1) * 32 + (swz % 64) / 2; }
__host__ __device__ __forceinline__ int perm32(int rho) { const int n = rho >> 4, i = rho & 15; return 8 * (i >> 2) + 4 * n + (i & 3); }

struct Unit { int pm, pn; };
struct Gemm { const bf16_t* A; const bf16_t* Bt; int M, N, K; };

struct StaticOrder {
    int nM, nN, nwg, G, c;
    __host__ __device__ void init(int M, int N, int G_, int c_) { nM = M / BM; nN = N / BM; nwg = nM * nN; G = G_; c = c_; }
    __host__ __device__ bool next(int i, Unit& u) const {
        const long L = (long)i * G + c; if (L >= nwg) return false;
        int wgid = (int)L; { const int q = nwg / NXCD, r = nwg % NXCD, xcd = wgid % NXCD, off = wgid / NXCD; wgid = (xcd < r ? xcd * (q + 1) : r * (q + 1) + (xcd - r) * q) + off; }
        const int nig = WGM * nN, gid = wgid / nig, fm = gid * WGM, gsz = (nM - fm) < WGM ? (nM - fm) : WGM;
        u.pm = fm + ((wgid % nig) % gsz); u.pn = (wgid % nig) / gsz; return true;
    }
    __device__ __forceinline__ void a_ready(const Unit&) const {}
    __device__ __forceinline__ void done(const Unit&) const {}
};

__device__ __forceinline__ unsigned cvt_pk_bf16(float lo, float hi) { unsigned r; asm volatile("v_cvt_pk_bf16_f32 %0, %1, %2" : "=v"(r) : "v"(lo), "v"(hi)); return r; }
__device__ __forceinline__ float sum_x16(float s) { auto r = __builtin_amdgcn_permlane16_swap(__float_as_uint(s), __float_as_uint(s), false, false); return __uint_as_float(r[0]) + __uint_as_float(r[1]); }
__device__ __forceinline__ float sum_x32(float s) { auto r = __builtin_amdgcn_permlane32_swap(__float_as_uint(s), __float_as_uint(s), false, false); return __uint_as_float(r[0]) + __uint_as_float(r[1]); }
__device__ __forceinline__ float peer_x16(float v, int fq) { auto r = __builtin_amdgcn_permlane16_swap(__float_as_uint(v), __float_as_uint(v), false, false); return __uint_as_float((fq & 1) ? r[0] : r[1]); }
constexpr float C2Q = 0.125f * 1.4426950408889634f;
__device__ __forceinline__ float row_rstd(const float* part, int row, int fq) {
    const float* pp = part + (size_t)(4 * fq) * 65536 + row; const f32x4 p = {pp[0], pp[65536], pp[2 * 65536], pp[3 * 65536]};
    float s = (p[0] + p[1]) + (p[2] + p[3]);
    s = sum_x16(s); s = sum_x32(s);
    return __builtin_amdgcn_rsqf(s * (1.0f / 1024.0f) + 1e-6f);
}
__device__ __forceinline__ void rows_part_load(const float* part, int row0  , int fq, f32x4 (&pl)[2][4]) {
#pragma unroll
    for (int ai = 0; ai < 2; ++ai)
#pragma unroll
        for (int m = 0; m < 4; ++m) { const float* pp = part + (size_t)(4 * fq) * 65536 + (row0 + ai * HALF + m * 16);
            pl[ai][m] = (f32x4){pp[0], pp[65536], pp[2 * 65536], pp[3 * 65536]}; }
}
__device__ __forceinline__ void rows_part_reduce(const f32x4 (&pl)[2][4], float (&rs)[2][4]) {
#pragma unroll
    for (int ai = 0; ai < 2; ++ai)
#pragma unroll
        for (int m = 0; m < 4; ++m) { float s = (pl[ai][m][0] + pl[ai][m][1]) + (pl[ai][m][2] + pl[ai][m][3]); s = sum_x16(s); s = sum_x32(s); rs[ai][m] = __builtin_amdgcn_rsqf(s * (1.0f / 1024.0f) + 1e-6f); }
}
__device__ __forceinline__ void rows_rstd(const float* part, int row0, int fq, float (&rs)[2][4]) { f32x4 pl[2][4]; rows_part_load(part, row0, fq, pl); rows_part_reduce(pl, rs); }
struct EpiProj {
    static constexpr bool PERM = true, AFTER_DRAIN = false, NEEDS_RSTD = true;
    bf16_t* proj; int ldp; const float* part; const float* cs; bf16_t* vt; bf16_t* kd; int odd;
    __device__ __forceinline__ void operator()(const f32x4 (&acc)[2][2][4][2], const Unit& u, int wr, int wc, int fr, int fq, PG8_LAS float* stash, int par, PG8_LAS unsigned char* stg, const Unit& un) const {
        const bool newpm = (un.pm != u.pm);
        f32x4 pln[2][4]; if (newpm) rows_part_load(part, un.pm * BM + wr * 64 + fr, fq, pln);
        float rsa[2][4];
#pragma unroll
        for (int ai = 0; ai < 2; ++ai)
#pragma unroll
            for (int m = 0; m < 4; ++m) rsa[ai][m] = stash[par * 256 + ai * HALF + wr * 64 + m * 16 + fr];
#pragma unroll
        for (int ai = 0; ai < 2; ++ai)
#pragma unroll
            for (int m = 0; m < 4; ++m) {
                if (m == 0) asm volatile("" ::: "memory");
                const int row = u.pm * BM + ai * HALF + wr * 64 + m * 16 + fr, pos = row & 4095, b = row >> 12;
                const float rs = rsa[ai][m];
#pragma unroll
                for (int bj = 0; bj < 2; ++bj) {
                    int kind;
                    if (odd) kind = (u.pn < 6) ? 0 : (u.pn == 6 ? 1 : 2);
                    else     kind = (u.pn < 2) ? 0 : (u.pn == 2 ? (wc < 2 ? 1 : 2) : 3);
                    float v[8];
#pragma unroll
                    for (int i = 0; i < 4; ++i) { v[i] = acc[ai][bj][m][0][i] * rs; v[4 + i] = acc[ai][bj][m][1][i] * rs; }
                    if (kind <= 1 && bj == 0) {
                        const f32x4 c0 = *(const f32x4*)(cs + pos * 16), c1 = *(const f32x4*)(cs + pos * 16 + 4), s0 = *(const f32x4*)(cs + pos * 16 + 8), s1 = *(const f32x4*)(cs + pos * 16 + 12);
#pragma unroll
                        for (int i = 0; i < 8; ++i) {
                            const float c = i < 4 ? c0[i & 3] : c1[i & 3], s = i < 4 ? s0[i & 3] : s1[i & 3];
                            const float pr = peer_x16(v[i], fq);
                            const float r = (fq == 0) ? (v[i] * c - pr * s) : (v[i] * c + pr * s);
                            v[i] = (fq < 2) ? r : v[i];
                        }
                    }
                    if (kind == 0) {
#pragma unroll
                        for (int i = 0; i < 8; ++i) v[i] *= C2Q;
                    }
                    { u32x4 w; w.x = cvt_pk_bf16(v[0], v[1]); w.y = cvt_pk_bf16(v[2], v[3]); w.z = cvt_pk_bf16(v[4], v[5]); w.w = cvt_pk_bf16(v[6], v[7]);
                      *(PG8_LAS u32x4*)(stg + fr * 144 + fq * 16 + bj * 64) = w; }
                }
                {
                    int kind;
                    if (odd) kind = (u.pn < 6) ? 0 : (u.pn == 6 ? 1 : 2);
                    else     kind = (u.pn < 2) ? 0 : (u.pn == 2 ? (wc < 2 ? 1 : 2) : 3);
#pragma unroll
                    for (int i = 0; i < 2; ++i) { const int c = fq * 16 + fr + 64 * i, rr = c >> 3, pc = c & 7;
                        const u32x4 w = *(const PG8_LAS u32x4*)(stg + rr * 144 + pc * 16);
                        const int rowc = row - fr + rr, posc = rowc & 4095;
                        if (kind == 1 || kind == 2) {
                            bf16_t* dst = (kind == 1) ? kd : vt;
                            if (odd) *(u32x4*)(dst + (size_t)(b * 4 + wc) * (4096 * 64) + (size_t)((posc & 15) * 256 + (posc >> 4)) * 64 + pc * 8) = w;
                            else     *(u32x4*)(dst + (size_t)(b * 2 + (wc & 1)) * (4096 * 64) + (size_t)posc * 64 + pc * 8) = w;
                        } else {
                            *(u32x4*)(proj + (size_t)rowc * ldp + u.pn * BM + wc * 64 + pc * 8) = w;
                        }
                    }
                }
            }
        if (newpm) { float rsn[2][4]; rows_part_reduce(pln, rsn);
          if (fq == 0) {
#pragma unroll
              for (int ai = 0; ai < 2; ++ai)
#pragma unroll
                  for (int m = 0; m < 4; ++m) stash[(par ^ 1) * 256 + ai * HALF + wr * 64 + m * 16 + fr] = rsn[ai][m]; } }
    }
};
struct EpiRes {
    static constexpr bool PERM = true, AFTER_DRAIN = false, NEEDS_RSTD = false;
    bf16_t* xb; float* part; bf16_t* xo_; float* po_;
    __device__ __forceinline__ void operator()(const f32x4 (&acc)[2][2][4][2], const Unit& u, int wr, int wc, int fr, int fq, PG8_LAS unsigned char* stg) const {
        const int lane = fq * 16 + fr;
        const size_t colw = (size_t)u.pn * BM + wc * 64;
        const int rowb = u.pm * BM + wr * 64;
        PG8_LAS unsigned char* st = stg + fr * 144 + fq * 16;
#pragma unroll
        for (int ai = 0; ai < 2; ++ai) {
        asm volatile("" ::: "memory");
        u32x4 xin[4][2];
#pragma unroll
        for (int m = 0; m < 4; ++m)
#pragma unroll
            for (int i = 0; i < 2; ++i) { const int c = lane + 64 * i; xin[m][i] = *(const u32x4*)(xb + (size_t)(rowb + ai * HALF + m * 16 + (c >> 3)) * 1024 + colw + (c & 7) * 8); }
#pragma unroll
        for (int m = 0; m < 4; ++m) {
            const int row = rowb + ai * HALF + m * 16 + fr;
#pragma unroll
            for (int i = 0; i < 2; ++i) { const int c = lane + 64 * i; *(PG8_LAS u32x4*)(stg + (c >> 3) * 144 + (c & 7) * 16) = xin[m][i]; }
            float ss = 0.f;
#pragma unroll
            for (int bj = 0; bj < 2; ++bj) {
                const u32x4 xo = *(const PG8_LAS u32x4*)(st + bj * 64);
                float v[8];
#pragma unroll
                for (int i = 0; i < 4; ++i) { v[2 * i] = __uint_as_float(xo[i] << 16) + acc[ai][bj][m][i >> 1][(2 * i) & 3]; v[2 * i + 1] = __uint_as_float(xo[i] & 0xffff0000u) + acc[ai][bj][m][i >> 1][(2 * i + 1) & 3]; }
                u32x4 w; w.x = cvt_pk_bf16(v[0], v[1]); w.y = cvt_pk_bf16(v[2], v[3]); w.z = cvt_pk_bf16(v[4], v[5]); w.w = cvt_pk_bf16(v[6], v[7]);
                *(PG8_LAS u32x4*)(st + bj * 64) = w;
                ss += ((v[0] * v[0] + v[1] * v[1]) + (v[2] * v[2] + v[3] * v[3])) + ((v[4] * v[4] + v[5] * v[5]) + (v[6] * v[6] + v[7] * v[7]));
            }
#pragma unroll
            for (int i = 0; i < 2; ++i) { const int c = lane + 64 * i; const u32x4 w = *(const PG8_LAS u32x4*)(stg + (c >> 3) * 144 + (c & 7) * 16);
                *(u32x4*)(xo_ + (size_t)(row - fr + (c >> 3)) * 1024 + colw + (c & 7) * 8) = w; }
            ss = sum_x16(ss); ss = sum_x32(ss);
            if (fq == 0) po_[(size_t)(u.pn * 4 + wc) * 65536 + row] = ss;
        }
        }
    }
};
struct EpiUp {
    static constexpr bool PERM = true, AFTER_DRAIN = false, NEEDS_RSTD = true;
    bf16_t* uo; const float* part;
    __device__ __forceinline__ void operator()(const f32x4 (&acc)[2][2][4][2], const Unit& u, int wr, int wc, int fr, int fq, PG8_LAS float* stash, int par, PG8_LAS unsigned char* stg, const Unit& un) const {
        const bool newpm = (un.pm != u.pm);
        f32x4 pln[2][4]; if (newpm) rows_part_load(part, un.pm * BM + wr * 64 + fr, fq, pln);
        float rsa[2][4];
#pragma unroll
        for (int ai = 0; ai < 2; ++ai)
#pragma unroll
            for (int m = 0; m < 4; ++m) rsa[ai][m] = stash[par * 256 + ai * HALF + wr * 64 + m * 16 + fr];
#pragma unroll
        for (int ai = 0; ai < 2; ++ai)
#pragma unroll
            for (int m = 0; m < 4; ++m) {
                const int row = u.pm * BM + ai * HALF + wr * 64 + m * 16 + fr;
                const float rs = rsa[ai][m];
                PG8_LAS unsigned char* st = stg + fr * 144 + fq * 16;
#pragma unroll
                for (int bj = 0; bj < 2; ++bj) {
                    float v[8];
#pragma unroll
                    for (int i = 0; i < 4; ++i) { v[i] = acc[ai][bj][m][0][i] * rs; v[4 + i] = acc[ai][bj][m][1][i] * rs; }
#pragma unroll
                    for (int i = 0; i < 8; ++i) { const float r = fmaxf(v[i], 0.f); v[i] = r * r; }
                    u32x4 w; w.x = cvt_pk_bf16(v[0], v[1]); w.y = cvt_pk_bf16(v[2], v[3]); w.z = cvt_pk_bf16(v[4], v[5]); w.w = cvt_pk_bf16(v[6], v[7]);
                    *(PG8_LAS u32x4*)(st + bj * 64) = w;
                }
#pragma unroll
                for (int i = 0; i < 2; ++i) { const int c = fq * 16 + fr + 64 * i, rr = c >> 3, pc = c & 7;
                    const u32x4 w = *(const PG8_LAS u32x4*)(stg + rr * 144 + pc * 16);
                    __builtin_nontemporal_store(w, (u32x4*)(uo + (size_t)(row - fr + rr) * 4096 + u.pn * BM + wc * 64 + pc * 8)); }
            }
        if (newpm) { float rsn[2][4]; rows_part_reduce(pln, rsn);
          if (fq == 0) {
#pragma unroll
              for (int ai = 0; ai < 2; ++ai)
#pragma unroll
                  for (int m = 0; m < 4; ++m) stash[(par ^ 1) * 256 + ai * HALF + wr * 64 + m * 16 + fr] = rsn[ai][m]; } }
    }
};
template <class Epi, class Sched, bool ALIGN_EPI = false, bool SP2 = false>
__device__ __forceinline__ void gemm_phase(PG8_LAS unsigned char* lds, const Gemm g, const Sched& S, const Epi& E, const int wave_s) {
    int tid_o; asm volatile("v_mbcnt_lo_u32_b32 %0, -1, 0\n\tv_mbcnt_hi_u32_b32 %0, -1, %0" : "=v"(tid_o)); tid_o += wave_s * 64;
    const int tid = tid_o, wid = __builtin_amdgcn_readfirstlane(tid >> 6), lane = tid & 63, wr = wid >> 2, wc = wid & 3, fr = lane & 15, fq = lane >> 4;
    const int K = g.K, nt = K / BK;
    unsigned voffA[2], voffB[2];
#pragma unroll
    for (int i = 0; i < 2; ++i) { int R, C; stage_rc(tid * 16 + i * 8192, R, C); const int Rb = Epi::PERM ? ((R >> 5) * 64 + perm32(R & 31)) : R;
        voffA[i] = (unsigned)(R * K + C) * 2u; voffB[i] = (unsigned)(Rb * K + C) * 2u; }
    const size_t kstep = (size_t)(BK * 2);
    const size_t hstep = (size_t)HALF * K * 2;
    const size_t bhstep = Epi::PERM ? (size_t)32 * K * 2 : hstep;
    const size_t tstep = 2 * hstep;
    const unsigned ldsw = (unsigned)wid * 1024u;
    const int aoff = lds_byte(wr * 64 + fr, fq * 8), boff = lds_byte(wc * 32 + fr, fq * 8);
#define PG8_SA(b, h) (((b) * 2 + (h)) * HTB)
#define PG8_SB(b, h) ((4 + (b) * 2 + (h)) * HTB)
#define PG8_STAGE(bufoff, gbase, voff) do { _Pragma("unroll") for (int _i = 0; _i < 2; ++_i) \
        __builtin_amdgcn_global_load_lds((const unsigned*)((const char*)(gbase) + (voff)[_i]), (PG8_LAS unsigned*)(lds + (bufoff) + ldsw + _i * 8192), 16, 0, 0); } while (0)
#define PG8_LDA(dst, b, h) do { _Pragma("unroll") for (int m = 0; m < 4; ++m) _Pragma("unroll") for (int k = 0; k < 2; ++k) dst[m][k] = *(const PG8_LAS bf16x8*)(lds + PG8_SA(b, h) + aoff + m * 2048 + k * 1024); } while (0)
#define PG8_LDB(dst, b, h) do { _Pragma("unroll") for (int n = 0; n < 2; ++n) _Pragma("unroll") for (int k = 0; k < 2; ++k) dst[n][k] = *(const PG8_LAS bf16x8*)(lds + PG8_SB(b, h) + boff + n * 2048 + k * 1024); } while (0)
#define PG8_MMA(ai, bj, At, Bt) do { __builtin_amdgcn_s_setprio(1); _Pragma("unroll") for (int m = 0; m < 4; ++m) _Pragma("unroll") for (int n = 0; n < 2; ++n) _Pragma("unroll") for (int k = 0; k < 2; ++k) \
        acc[ai][bj][m][n] = __builtin_amdgcn_mfma_f32_16x16x32_bf16(Bt[n][k], At[m][k], acc[ai][bj][m][n], 0, 0, 0); __builtin_amdgcn_s_setprio(0); } while (0)
#define PG8_WAIT_V(n) asm volatile("s_waitcnt vmcnt(" #n ")" ::: "memory")
#define PG8_WAIT_L(n) asm volatile("s_waitcnt lgkmcnt(" #n ")" ::: "memory")
#define PG8_BAR __builtin_amdgcn_s_barrier()
#define PG8_SCHED __builtin_amdgcn_sched_barrier(0)
    Unit cur, nxt; int ui = 0;
    if (!S.next(0, cur)) return;
    PG8_LAS float* rs_stash = (PG8_LAS float*)(lds + STAGE_BYTES); int rs_par = 0;
    if constexpr (Epi::NEEDS_RSTD) { float rs0[2][4]; rows_rstd(E.part, cur.pm * BM + wr * 64 + fr, fq, rs0);
        if (fq == 0) {
#pragma unroll
            for (int ai = 0; ai < 2; ++ai)
#pragma unroll
                for (int m = 0; m < 4; ++m) rs_stash[ai * HALF + wr * 64 + m * 16 + fr] = rs0[ai][m]; } }
    f32x4 acc[2][2][4][2];
#pragma unroll
    for (int a = 0; a < 2; ++a)
#pragma unroll
        for (int b = 0; b < 2; ++b)
#pragma unroll
            for (int m = 0; m < 4; ++m)
#pragma unroll
                for (int n = 0; n < 2; ++n) acc[a][b][m][n] = (f32x4){0.f, 0.f, 0.f, 0.f};
    bf16x8 At[4][2], B0[2][2], B1[2][2];
    const char* cA = (const char*)g.A + (size_t)cur.pm * tstep; const char* cB = (const char*)g.Bt + (size_t)cur.pn * tstep;
    S.a_ready(cur);
    if constexpr (SP2) {
        PG8_STAGE(PG8_SB(0, 0), cB, voffB); PG8_STAGE(PG8_SB(0, 1), cB + bhstep, voffB); PG8_STAGE(PG8_SA(0, 0), cA, voffA); PG8_STAGE(PG8_SA(0, 1), cA + hstep, voffA);
        if (wr == 1) PG8_BAR;
        PG8_WAIT_V(2); PG8_BAR;
        PG8_STAGE(PG8_SB(1, 0), cB + kstep, voffB); PG8_STAGE(PG8_SA(1, 0), cA + kstep, voffA); PG8_STAGE(PG8_SB(1, 1), cB + bhstep + kstep, voffB);
        PG8_WAIT_V(6); PG8_BAR;
    } else {
        PG8_STAGE(PG8_SB(0, 0), cB, voffB); PG8_STAGE(PG8_SA(0, 0), cA, voffA); PG8_STAGE(PG8_SB(0, 1), cB + bhstep, voffB); PG8_STAGE(PG8_SA(0, 1), cA + hstep, voffA);
        if (wr == 1) PG8_BAR;
        PG8_WAIT_V(4); PG8_BAR;
        PG8_STAGE(PG8_SB(1, 0), cB + kstep, voffB); PG8_STAGE(PG8_SA(1, 0), cA + kstep, voffA); PG8_STAGE(PG8_SB(1, 1), cB + bhstep + kstep, voffB);
        PG8_WAIT_V(6); PG8_BAR;
    }
    for (;;) {
        const bool has_next = S.next(ui + 1, nxt);
        const char* nA = has_next ? (const char*)g.A + (size_t)nxt.pm * tstep : cA; const char* nB = has_next ? (const char*)g.Bt + (size_t)nxt.pn * tstep : cB;
        for (int t = 0; t < nt; t += 2) {
            const bool last = (t == nt - 2);
            const char* a1 = cA + (size_t)(t + 1) * kstep;
            const char* a2 = last ? nA : cA + (size_t)(t + 2) * kstep; const char* b2 = last ? nB : cB + (size_t)(t + 2) * kstep;
            const char* a3 = a2 + kstep; const char* b3 = b2 + kstep;
            if (last && has_next) S.a_ready(nxt);
            if constexpr (SP2) {
            PG8_LDB(B0, 0, 0); PG8_LDB(B1, 0, 1); PG8_SCHED; PG8_LDA(At, 0, 0); PG8_STAGE(PG8_SA(1, 1), a1 + hstep, voffA);
            PG8_WAIT_V(8); PG8_WAIT_L(0); PG8_BAR; PG8_MMA(0, 0, At, B0); PG8_MMA(0, 1, At, B1); PG8_BAR; PG8_SCHED;
            PG8_LDA(At, 0, 1); PG8_STAGE(PG8_SB(0, 0), b2, voffB); PG8_STAGE(PG8_SB(0, 1), b2 + bhstep, voffB); PG8_STAGE(PG8_SA(0, 0), a2, voffA);
            PG8_WAIT_V(8); PG8_WAIT_L(0); PG8_BAR; PG8_MMA(1, 0, At, B0); PG8_MMA(1, 1, At, B1); PG8_BAR; PG8_SCHED;
            PG8_LDB(B0, 1, 0); PG8_LDB(B1, 1, 1); PG8_SCHED; PG8_LDA(At, 1, 0); PG8_STAGE(PG8_SA(0, 1), a2 + hstep, voffA);
            PG8_WAIT_V(8); PG8_WAIT_L(0); PG8_BAR; PG8_MMA(0, 0, At, B0); PG8_MMA(0, 1, At, B1); PG8_BAR; PG8_SCHED;
            PG8_LDA(At, 1, 1); PG8_STAGE(PG8_SB(1, 0), b3, voffB); PG8_STAGE(PG8_SB(1, 1), b3 + bhstep, voffB); PG8_STAGE(PG8_SA(1, 0), a3, voffA);
            PG8_WAIT_V(8); PG8_WAIT_L(0); PG8_BAR; PG8_MMA(1, 0, At, B0); PG8_MMA(1, 1, At, B1); PG8_BAR; PG8_SCHED;
            } else {
            PG8_LDB(B0, 0, 0); PG8_SCHED; PG8_LDA(At, 0, 0); PG8_STAGE(PG8_SA(1, 1), a1 + hstep, voffA);
            PG8_WAIT_L(8); PG8_BAR; PG8_WAIT_L(0); PG8_MMA(0, 0, At, B0); PG8_BAR; PG8_SCHED;
            PG8_LDB(B1, 0, 1); PG8_STAGE(PG8_SB(0, 0), b2, voffB);
            PG8_BAR; PG8_WAIT_L(0); PG8_MMA(0, 1, At, B1); PG8_BAR;
            PG8_LDA(At, 0, 1); PG8_STAGE(PG8_SA(0, 0), a2, voffA);
            PG8_BAR; PG8_WAIT_L(0); PG8_MMA(1, 0, At, B0); PG8_BAR; PG8_SCHED;
            PG8_STAGE(PG8_SB(0, 1), b2 + bhstep, voffB);
            PG8_WAIT_V(6); PG8_BAR; PG8_MMA(1, 1, At, B1); PG8_BAR;
            PG8_LDB(B0, 1, 0); PG8_SCHED; PG8_LDA(At, 1, 0); PG8_STAGE(PG8_SA(0, 1), a2 + hstep, voffA);
            PG8_WAIT_L(8); PG8_BAR; PG8_WAIT_L(0); PG8_MMA(0, 0, At, B0); PG8_BAR; PG8_SCHED;
            PG8_LDB(B1, 1, 1); PG8_STAGE(PG8_SB(1, 0), b3, voffB);
            PG8_BAR; PG8_WAIT_L(0); PG8_MMA(0, 1, At, B1); PG8_BAR;
            PG8_LDA(At, 1, 1); PG8_STAGE(PG8_SA(1, 0), a3, voffA);
            PG8_BAR; PG8_WAIT_L(0); PG8_MMA(1, 0, At, B0); PG8_BAR; PG8_SCHED;
            PG8_STAGE(PG8_SB(1, 1), b3 + bhstep, voffB);
            PG8_WAIT_V(6); PG8_BAR; PG8_MMA(1, 1, At, B1); PG8_BAR;
            }
        }
        if constexpr (ALIGN_EPI) { if (wr == 0) PG8_BAR; }
        if constexpr (!Epi::AFTER_DRAIN) { if constexpr (Epi::NEEDS_RSTD) E(acc, cur, wr, wc, fr, fq, rs_stash, rs_par, (PG8_LAS unsigned char*)(lds + STAGE_BYTES + 2048 + wid * 2304), has_next ? nxt : cur); else E(acc, cur, wr, wc, fr, fq, (PG8_LAS unsigned char*)(lds + STAGE_BYTES + 2048 + wid * 2304)); S.done(cur); }
        if (!has_next) break;
#pragma unroll
        for (int a = 0; a < 2; ++a)
#pragma unroll
            for (int b = 0; b < 2; ++b)
#pragma unroll
                for (int m = 0; m < 4; ++m)
#pragma unroll
                    for (int n = 0; n < 2; ++n) acc[a][b][m][n] = (f32x4){0.f, 0.f, 0.f, 0.f};
        if (nxt.pm != cur.pm) rs_par ^= 1;
        cur = nxt; cA = nA; cB = nB; ++ui;
        if constexpr (ALIGN_EPI) { if (wr == 1) PG8_BAR; }
    }
    PG8_WAIT_V(0);
    if constexpr (!ALIGN_EPI) { if (wr == 0) PG8_BAR; }
    PG8_BAR;
    if constexpr (Epi::AFTER_DRAIN) { E.fused(acc, cur, wr, wc, fr, fq, lds, wid, lane); S.done(cur); }
#undef PG8_SA
#undef PG8_SB
#undef PG8_STAGE
#undef PG8_LDA
#undef PG8_LDB
#undef PG8_MMA
#undef PG8_WAIT_V
#undef PG8_WAIT_L
#undef PG8_BAR
#undef PG8_SCHED
}
}
#define LAS __attribute__((address_space(3)))
typedef pg8::bf16_t bf16_t;
typedef short bf16x8 __attribute__((ext_vector_type(8)));
typedef float f32x4 __attribute__((ext_vector_type(4)));
typedef float f32x16 __attribute__((ext_vector_type(16)));
typedef unsigned u32x4 __attribute__((ext_vector_type(4)));
typedef unsigned u32x2 __attribute__((ext_vector_type(2)));

constexpr int NTOK = 65536, DM = 1024, SEQ = 4096, NB = 16, DFF = 4096;
constexpr int NWAVES = 8, NTHREADS = 512;
constexpr int LDS_BYTES = 131072, LDS_ALLOC = 163840, WAVE_LDS = 20480, MISC_OFF = LDS_ALLOC - 256;
constexpr size_t MiB = (size_t)1 << 20;
constexpr size_t WS_WIN_E = 0, WS_WOUT_E = 5 * MiB, WS_WIN_O = 9 * MiB, WS_WOUT_O = 17 * MiB, WS_WUP = 19 * MiB, WS_WDN = 51 * MiB;
constexpr size_t WS_WF = 83 * MiB, WS_CS = 87 * MiB, WS_PART = 88 * MiB, WS_BAR = 92 * MiB, WS_LSE = 93 * MiB, WS_XB = 96 * MiB, WS_BIG = 224 * MiB;
constexpr size_t WS_PROJ = WS_BIG, WS_VT = WS_BIG + 256 * MiB, WS_MIX = WS_BIG + 352 * MiB, WS_KD = WS_BIG + 480 * MiB, WS_U = WS_BIG, WS_END = WS_BIG + 576 * MiB;

struct Params {
    const float *x, *norm_mix, *norm_mlp, *norm_final, *w_in_even, *w_out_even, *sink, *w_pool, *pool_scale, *w_in_odd, *w_out_odd, *w_up, *w_down;
    float* out; unsigned char* ws;
};

__device__ __forceinline__ unsigned pk2(float lo, float hi) { return pg8::cvt_pk_bf16(lo, hi); }
__device__ __forceinline__ float wave_sum(float v) {
#pragma unroll
    for (int o = 1; o < 64; o <<= 1) v += __shfl_xor(v, o);
    return v;
}

#define XB_TMO      128
#define XB_XCNT(j)  (256  + 64 * (j))
#define XB_XSUB(j)  (1280 + 64 * (j))
#define XB_XGEN(j)  (2304 + 64 * (j))
#define XB_TOP      3328
#define XB_TOPGEN   3392
#define XCD_BAR_WORDS 3456
#define XB_SPIN_CAP (1u << 22)
__device__ __forceinline__ unsigned xb_ld(unsigned* p)              { return __hip_atomic_load(p, __ATOMIC_RELAXED, __HIP_MEMORY_SCOPE_AGENT); }
__device__ __forceinline__ unsigned xb_add(unsigned* p, unsigned v) { return __hip_atomic_fetch_add(p, v, __ATOMIC_RELAXED, __HIP_MEMORY_SCOPE_AGENT); }
__device__ __forceinline__ unsigned xb_xcc_id() { return (unsigned)__builtin_amdgcn_s_getreg((3 << 11) | 20) & 0xFu; }
#define XB_SPIN(cond, bar) do { unsigned _sp = 0; while (cond) { __builtin_amdgcn_s_sleep(1); \
    if ((++_sp & 255u) == 0u) { if (xb_ld(&(bar)[XB_TMO])) break; if (_sp > XB_SPIN_CAP) { atomicAdd(&(bar)[XB_TMO], 1u); break; } } } } while (0)
struct XcdBarrier { unsigned* bar; unsigned x; volatile LAS unsigned* st; };
__device__ __forceinline__ bool wg_leader(int wave) { int ln; asm volatile("v_mbcnt_lo_u32_b32 %0, -1, 0\n\tv_mbcnt_hi_u32_b32 %0, -1, %0" : "=v"(ln)); return wave == 0 && ln == 0; }
__device__ __forceinline__ XcdBarrier xcd_barrier_post(unsigned* bar, volatile LAS unsigned* st, int wave) {
    XcdBarrier b; b.bar = bar; b.x = xb_xcc_id(); b.st = st;
    if (wg_leader(wave)) (void)xb_add(&bar[XB_XCNT(b.x)], 1u);
    return b;
}
__device__ __forceinline__ void xcd_barrier_complete(unsigned* bar, unsigned x, unsigned& nloc, unsigned& nx) {
    const unsigned G = gridDim.x * gridDim.y * gridDim.z;
    unsigned sum, cnt, mine, sp = 0u;
    for (;;) {
        sum = 0u; cnt = 0u; mine = 0u;
#pragma unroll
        for (unsigned j = 0; j < 16; ++j) { const unsigned c = xb_ld(&bar[XB_XCNT(j)]); sum += c; cnt += (c > 0u) ? 1u : 0u; mine = (j == x) ? c : mine; }
        if (sum == G) break;
        __builtin_amdgcn_s_sleep(1);
        if ((++sp & 255u) == 0u) { if (xb_ld(&bar[XB_TMO])) break; if (sp > XB_SPIN_CAP) { atomicAdd(&bar[XB_TMO], 1u); break; } }
    }
    nloc = mine > 0u ? mine : 1u; nx = cnt > 0u ? cnt : 1u;
}
__device__ __forceinline__ void xcd_barrier(const XcdBarrier& b, int wave) {
    asm volatile("s_waitcnt vmcnt(0)" ::: "memory");
    __syncthreads();
    if (wg_leader(wave)) {
        unsigned* bar = b.bar;
        __builtin_amdgcn_s_waitcnt(0);
        unsigned nloc = b.st[0], nx = b.st[1];
        if (nloc == 0u) { xcd_barrier_complete(bar, b.x, nloc, nx); b.st[0] = nloc; b.st[1] = nx; }
        const unsigned old = xb_add(&bar[XB_XSUB(b.x)], 1u);
        const unsigned gen = old / nloc;
        if (old + 1u == (gen + 1u) * nloc) {
            __builtin_amdgcn_fence(__ATOMIC_RELEASE, "agent");
            asm volatile("s_waitcnt vmcnt(0)" ::: "memory");
            const unsigned og = xb_add(&bar[XB_TOP], 1u);
            const unsigned tg = og / nx;
            if (og + 1u == (tg + 1u) * nx) xb_add(&bar[XB_TOPGEN], 1u);
            else XB_SPIN(xb_ld(&bar[XB_TOPGEN]) == tg, bar);
            __builtin_amdgcn_fence(__ATOMIC_ACQUIRE, "agent");
            xb_add(&bar[XB_XGEN(b.x)], 1u);
            asm volatile("s_waitcnt vmcnt(0)" ::: "memory");
        } else {
            XB_SPIN(xb_ld(&bar[XB_XGEN(b.x)]) == gen, bar);
            __builtin_amdgcn_fence(__ATOMIC_ACQUIRE, "agent");
            asm volatile("s_waitcnt vmcnt(0)" ::: "memory");
        }
    }
    __syncthreads();
}

__device__ __forceinline__ void transpose_item(const float* W, const float* gain, int N, bf16_t* WT, int ldk, int koff, LAS float* scr, int item, int lane) {
    const int nblk = N / 32, kb = item / nblk, nb = item % nblk, k0 = 64 * kb, n0 = 32 * nb;
    const int c4 = lane & 7, kr = lane >> 3;
#pragma unroll
    for (int i = 0; i < 8; ++i) { const int kk = 8 * i + kr; const float g = gain ? gain[k0 + kk] : 1.f; const f32x4 v = *(const f32x4*)(W + (size_t)(k0 + kk) * N + n0 + 4 * c4);
        LAS float* d = scr + kk * 33 + 4 * c4; d[0] = v[0] * g; d[1] = v[1] * g; d[2] = v[2] * g; d[3] = v[3] * g; }
    asm volatile("s_waitcnt lgkmcnt(0)" ::: "memory");
    const int c = lane & 7;
#pragma unroll
    for (int j = 0; j < 4; ++j) { const int n = (lane >> 3) + 8 * j; const LAS float* s = scr + (8 * c) * 33 + n;
        u32x4 o; o.x = pk2(s[0 * 33], s[1 * 33]); o.y = pk2(s[2 * 33], s[3 * 33]); o.z = pk2(s[4 * 33], s[5 * 33]); o.w = pk2(s[6 * 33], s[7 * 33]);
        *(u32x4*)(WT + (size_t)(n0 + n) * ldk + koff + k0 + 8 * c) = o; }
    asm volatile("s_waitcnt lgkmcnt(0)" ::: "memory");
}
struct Job { const float* W; const float* g; int Kr, N; bf16_t* WT; int ldk, koff; };
__device__ __forceinline__ Job get_job(const Params& p, int j) {
    Job J; unsigned char* ws = p.ws;
    if (j < 6) { const int e = j / 3, t = j % 3;
        if (t == 0) { J.W = p.w_in_even + (size_t)e * 1024 * 1280; J.g = p.norm_mix + (2 * e) * 1024; J.Kr = 1024; J.N = 1280; J.WT = (bf16_t*)(ws + WS_WIN_E) + (size_t)e * 1280 * 1024; J.ldk = 1024; J.koff = 0; }
        else if (t == 1) { J.W = p.w_out_even + (size_t)e * 1024 * 1024; J.g = nullptr; J.Kr = 512; J.N = 1024; J.WT = (bf16_t*)(ws + WS_WOUT_E) + (size_t)e * 1024 * 1024; J.ldk = 1024; J.koff = 0; }
        else { J.W = p.w_out_even; J.g = nullptr; J.Kr = 0; J.N = 1024; J.WT = (bf16_t*)(ws + WS_WOUT_E) + (size_t)e * 1024 * 1024; J.ldk = 1024; J.koff = 512; }
    } else if (j < 10) { const int o = (j - 6) / 2, t = (j - 6) % 2;
        if (t == 0) { J.W = p.w_in_odd + (size_t)o * 1024 * 2048; J.g = p.norm_mix + (2 * o + 1) * 1024; J.Kr = 1024; J.N = 2048; J.WT = (bf16_t*)(ws + WS_WIN_O) + (size_t)o * 2048 * 1024; J.ldk = 1024; J.koff = 0; }
        else { J.W = p.w_out_odd + (size_t)o * 512 * 1024; J.g = nullptr; J.Kr = 512; J.N = 1024; J.WT = (bf16_t*)(ws + WS_WOUT_O) + (size_t)o * 1024 * 512; J.ldk = 512; J.koff = 0; }
    } else { const int l = (j - 10) / 2, t = (j - 10) % 2;
        if (t == 0) { J.W = p.w_up + (size_t)l * 1024 * 4096; J.g = p.norm_mlp + l * 1024; J.Kr = 1024; J.N = 4096; J.WT = (bf16_t*)(ws + WS_WUP) + (size_t)l * 4096 * 1024; J.ldk = 1024; J.koff = 0; }
        else { J.W = p.w_down + (size_t)l * 4096 * 1024; J.g = nullptr; J.Kr = 4096; J.N = 1024; J.WT = (bf16_t*)(ws + WS_WDN) + (size_t)l * 1024 * 4096; J.ldk = 4096; J.koff = 0; }
    }
    return J;
}
constexpr int NJOBS = 18;

__device__ __forceinline__ void sincos_d(float a, float& c, float& s) {
    const double x = (double)a; const double k = __builtin_rint(x * 0.63661977236758134308);
    const double r = x - k * 1.57079632679489661923; const double r2 = r * r;
    double sp = -1.0 / 1307674368000.0; sp = sp * r2 + 1.0 / 6227020800.0; sp = sp * r2 - 1.0 / 39916800.0; sp = sp * r2 + 1.0 / 362880.0; sp = sp * r2 - 1.0 / 5040.0; sp = sp * r2 + 1.0 / 120.0; sp = sp * r2 - 1.0 / 6.0; sp = sp * r2 + 1.0;
    const double sn = sp * r;
    double cp = 1.0 / 20922789888000.0; cp = cp * r2 - 1.0 / 87178291200.0; cp = cp * r2 + 1.0 / 479001600.0; cp = cp * r2 - 1.0 / 3628800.0; cp = cp * r2 + 1.0 / 40320.0; cp = cp * r2 - 1.0 / 720.0; cp = cp * r2 + 1.0 / 24.0; cp = cp * r2 - 0.5; cp = cp * r2 + 1.0;
    const int q = ((int)k) & 3;
    const double cc = (q == 0) ? cp : (q == 1) ? -sn : (q == 2) ? -cp : sn;
    const double ss = (q == 0) ? sn : (q == 1) ? cp : (q == 2) ? -sn : -cp;
    c = (float)cc; s = (float)ss;
}

struct KVFrag { bf16x8 kr[4]; bf16x8 vr[4]; };
__device__ __forceinline__ void load_frags(KVFrag& f, const bf16_t* K0, const bf16_t* V0, int kb, int mode, int rsel, int lane) {
    if (mode == 0) {
        const int eo = kb * 64 + lane * 8;
        const bf16_t* kp = K0 + eo; const bf16_t* vp = V0 + eo;
#pragma unroll
        for (int i = 0; i < 4; ++i) { f.kr[i] = *(const bf16x8*)(kp + 512 * i); f.vr[i] = *(const bf16x8*)(vp + 512 * i); }
    } else if (mode == 1) {
        const int k0 = lane >> 3;
        const int eo = ((((k0 & 3) * 4 + rsel) * 256) + (kb >> 2) + (k0 >> 2)) * 64 + (lane & 7) * 8;
        const bf16_t* kp = K0 + eo; const bf16_t* vp = V0 + eo;
#pragma unroll
        for (int i = 0; i < 4; ++i) { f.kr[i] = *(const bf16x8*)(kp + 128 * i); f.vr[i] = *(const bf16x8*)(vp + 128 * i); }
    } else {
        const int k0 = lane >> 3;
        const int eo = (k0 * 256 + (kb >> 4)) * 64 + (lane & 7) * 8;
        const bf16_t* kp = K0 + eo; const bf16_t* vp = V0 + eo;
#pragma unroll
        for (int i = 0; i < 4; ++i) { const int o = (i & 1) * (8 * 256 * 64) + (i >> 1) * 64; f.kr[i] = *(const bf16x8*)(kp + o); f.vr[i] = *(const bf16x8*)(vp + o); }
    }
}
typedef short s16x4 __attribute__((ext_vector_type(4)));
constexpr int KST_OFF = 6144, KST_RS = 144;
constexpr int VST_RS = 192;
struct HState { f32x16 o[2]; float m, l; };
__device__ __forceinline__ void stage_v(const KVFrag& f, LAS unsigned char* vst, int lane, int hi, bf16x8 (&vf)[2][2], bf16x8 (&kf)[4]) {
#pragma unroll
    for (int i = 0; i < 4; ++i) { const int c = lane + 64 * i; *(LAS bf16x8*)(vst + (c >> 3) * VST_RS + (c & 7) * 16) = f.vr[i]; *(LAS bf16x8*)(vst + KST_OFF + (c >> 3) * KST_RS + (c & 7) * 16) = f.kr[i]; }
    const LAS unsigned char* tb = vst + (8 * hi + ((lane & 15) >> 2)) * VST_RS + (16 * ((lane >> 4) & 1) + 4 * (lane & 3)) * 2;
#pragma unroll
    for (int ks = 0; ks < 2; ++ks)
#pragma unroll
        for (int dh = 0; dh < 2; ++dh) {
            const s16x4 lo = __builtin_bit_cast(s16x4, __builtin_amdgcn_ds_read_tr16_b64_v4i16((LAS s16x4*)(tb + (16 * ks) * VST_RS + dh * 64)));
            const s16x4 hi4 = __builtin_bit_cast(s16x4, __builtin_amdgcn_ds_read_tr16_b64_v4i16((LAS s16x4*)(tb + (16 * ks + 4) * VST_RS + dh * 64)));
            vf[ks][dh] = (bf16x8){lo[0], lo[1], lo[2], lo[3], hi4[0], hi4[1], hi4[2], hi4[3]};
        }
    const int l31 = lane & 31, jsw = (l31 & 0x13) | ((l31 & 4) << 1) | ((l31 & 8) >> 1);
    const LAS unsigned char* kb_ = vst + KST_OFF + jsw * KST_RS + 16 * hi;
#pragma unroll
    for (int d0 = 0; d0 < 4; ++d0) kf[d0] = *(const LAS bf16x8*)(kb_ + 32 * d0);
}
struct ORows { unsigned base_row, pstride, amask, ashift, ld, hcol; };
__device__ __forceinline__ unsigned orow_off(const ORows& R, int rr) { return (R.base_row + R.pstride * ((unsigned)rr & R.amask)) * R.ld + R.hcol + 64u * ((unsigned)rr >> R.ashift); }
constexpr int QST_RS = 144, QST_SET = 32 * QST_RS;
__device__ __forceinline__ void qk_tile(const bf16x8 (&kf)[4], const LAS unsigned char* qh, f32x16& s) {
    const f32x16 z = {0.f, 0.f, 0.f, 0.f, 0.f, 0.f, 0.f, 0.f, 0.f, 0.f, 0.f, 0.f, 0.f, 0.f, 0.f, 0.f};
    s = __builtin_amdgcn_mfma_f32_32x32x16_bf16(kf[0], *(const LAS bf16x8*)qh, z, 0, 0, 0);
#pragma unroll
    for (int d0 = 1; d0 < 4; ++d0) s = __builtin_amdgcn_mfma_f32_32x32x16_bf16(kf[d0], *(const LAS bf16x8*)(qh + 32 * d0), s, 0, 0, 0);
}
__device__ __forceinline__ void q_rows_load(const bf16_t* proj, const ORows& R, int lane, u32x4 (&qv)[4]) {
#pragma unroll
    for (int i = 0; i < 4; ++i) { const int c = lane + 64 * i; qv[i] = *(const u32x4*)(proj + (orow_off(R, c >> 3) + (unsigned)((c & 7) * 8))); }
}
__device__ __forceinline__ void q_rows_stage(const u32x4 (&qv)[4], LAS unsigned char* qset, int lane) {
#pragma unroll
    for (int i = 0; i < 4; ++i) { const int c = lane + 64 * i; *(LAS u32x4*)(qset + (c >> 3) * QST_RS + (c & 7) * 16) = qv[i]; }
}
__device__ __forceinline__ float max3f(float a, float b, float c) { return fmaxf(fmaxf(a, b), c); }
__device__ __forceinline__ float max2f(float a, float b) { return fmaxf(a, b); }
typedef float f32x2 __attribute__((ext_vector_type(2)));
typedef __bf16 bf16x2_t __attribute__((ext_vector_type(2)));
__device__ __forceinline__ unsigned cvtpk_s(float lo, float hi) { f32x2 v = {lo, hi}; bf16x2_t b = __builtin_convertvector(v, bf16x2_t); return __builtin_bit_cast(unsigned, b); }
__device__ __forceinline__ void softmax_head(f32x16& s, int kb, int lq, int radius, bool full, int hi, HState& S) {
    if (!full) {
#pragma unroll
        for (int r = 0; r < 16; ++r) { const int lk = kb + 16 * (r >> 3) + 8 * hi + (r & 7); const int d = lk - lq;
            const bool valid = (unsigned)(d + radius) <= (unsigned)(2 * radius); s[r] = valid ? s[r] : -INFINITY; }
    }
    float t0 = max3f(s[0], s[1], s[2]), t1 = max3f(s[3], s[4], s[5]);
    t0 = max3f(t0, s[6], s[7]); t1 = max3f(t1, s[8], s[9]); t0 = max3f(t0, s[10], s[11]); t1 = max3f(t1, s[12], s[13]);
    float tmax = max3f(t0, s[14], s[15]); tmax = max2f(tmax, t1);
    { auto rr = __builtin_amdgcn_permlane32_swap(__float_as_uint(tmax), __float_as_uint(tmax), false, false); tmax = max2f(__uint_as_float(rr[0]), __uint_as_float(rr[1])); }
    if (__builtin_amdgcn_ballot_w64(tmax > S.m + 8.0f) != 0ull) {
        const float mn = max2f(S.m, tmax), alpha = __builtin_amdgcn_exp2f(S.m - mn); S.m = mn; S.l *= alpha;
#pragma unroll
        for (int dh = 0; dh < 2; ++dh)
#pragma unroll
            for (int r = 0; r < 16; ++r) S.o[dh][r] *= alpha;
    }
}
__device__ __forceinline__ void softmax_tail(f32x16& s, HState& S, u32x4 (&pw)[2]) {
    const float mn = S.m;
#pragma unroll
    for (int r = 0; r < 16; ++r) s[r] -= mn;
#pragma unroll
    for (int r = 0; r < 16; ++r) s[r] = __builtin_amdgcn_exp2f(s[r]);
    float p0 = s[0], p1 = s[1];
#pragma unroll
    for (int r = 2; r < 16; r += 2) { p0 += s[r]; p1 += s[r + 1]; }
    S.l += p0 + p1;
#pragma unroll
    for (int ks = 0; ks < 2; ++ks) { pw[ks].x = cvtpk_s(s[8 * ks + 0], s[8 * ks + 1]); pw[ks].y = cvtpk_s(s[8 * ks + 2], s[8 * ks + 3]); pw[ks].z = cvtpk_s(s[8 * ks + 4], s[8 * ks + 5]); pw[ks].w = cvtpk_s(s[8 * ks + 6], s[8 * ks + 7]); }
}
__device__ __forceinline__ void softmax_tile(f32x16& s, int kb, int lq, int radius, bool full, int hi, HState& S, u32x4 (&pw)[2]) { softmax_head(s, kb, lq, radius, full, hi, S); softmax_tail(s, S, pw); }
#define MFMA_VALU_INTERLEAVE() do { _Pragma("unroll") for (int g_ = 0; g_ < 4; ++g_) { __builtin_amdgcn_sched_group_barrier(0x008, 1, 0); __builtin_amdgcn_sched_group_barrier(0x002, 14, 0); } } while (0)
#ifndef XTRA_MFMA
#define XTRA_MFMA 0
#endif
__device__ __forceinline__ void pv_tile(const bf16x8 (&vf)[2][2], const u32x4 (&pw)[2], HState& S) {
#pragma unroll
    for (int ks = 0; ks < 2; ++ks)
#pragma unroll
        for (int dh = 0; dh < 2; ++dh) S.o[dh] = __builtin_amdgcn_mfma_f32_32x32x16_bf16(vf[ks][dh], __builtin_bit_cast(bf16x8, pw[ks]), S.o[dh], 0, 0, 0);
    if (XTRA_MFMA) {
        u32x4 zz = {0u, 0u, 0u, 0u}; asm volatile("" : "+v"(zz));
#pragma unroll
        for (int k = 0; k < XTRA_MFMA; ++k) S.o[k & 1] = __builtin_amdgcn_mfma_f32_32x32x16_bf16(vf[0][k & 1], __builtin_bit_cast(bf16x8, zz), S.o[k & 1], 0, 0, 0);
    }
}
struct QSet { int lq, lqmin, lqmax; };
template <int NH>
__device__ __forceinline__ void tile_all(const KVFrag& f, const LAS unsigned char* ql, LAS unsigned char* vst, int lane, int hi, int kb, int radius, const QSet& qa, const QSet& qb, HState& A, HState& B) {
    bf16x8 vf[2][2], kf[4]; stage_v(f, vst, lane, hi, vf, kf);
    f32x16 sa; u32x4 pwa[2];
    qk_tile(kf, ql, sa);
    if (NH == 1) {
        softmax_tile(sa, kb, qa.lq, radius, (kb >= qa.lqmax - radius) && (kb + 31 <= qa.lqmin + radius), hi, A, pwa);
        pv_tile(vf, pwa, A);
    } else {
        f32x16 sb; u32x4 pwb[2];
        softmax_head(sa, kb, qa.lq, radius, (kb >= qa.lqmax - radius) && (kb + 31 <= qa.lqmin + radius), hi, A);
        __builtin_amdgcn_sched_barrier(0);
        qk_tile(kf, ql + QST_SET, sb);
        softmax_tail(sa, A, pwa);
        MFMA_VALU_INTERLEAVE();
        __builtin_amdgcn_sched_barrier(0);
        softmax_head(sb, kb, qb.lq, radius, (kb >= qb.lqmax - radius) && (kb + 31 <= qb.lqmin + radius), hi, B);
        __builtin_amdgcn_sched_barrier(0);
        pv_tile(vf, pwa, A);
        softmax_tail(sb, B, pwb);
        MFMA_VALU_INTERLEAVE();
        __builtin_amdgcn_sched_barrier(0);
        pv_tile(vf, pwb, B);
    }
}
template <int NH>
__device__ __forceinline__ void attn_pass(const LAS unsigned char* ql, LAS unsigned char* vst, int lane, const bf16_t* K0, const bf16_t* V0, int mode, int rsel, int L, int kb0, int nt, int radius,
                                          const QSet& qa, const QSet& qb, HState& A, HState& B) {
    const int lane31 = lane & 31, hi = lane >> 5;
    const int jsw = (lane31 & 0x13) | ((lane31 & 4) << 1) | ((lane31 & 8) >> 1);
    const int ilo = kb0 < 0 ? ((-kb0) >> 5) : 0, ihi = min(nt, (L - kb0) >> 5);
    if (ilo >= ihi) return;
    KVFrag fa, fb;
    load_frags(fa, K0, V0, kb0 + 32 * ilo, mode, rsel, lane);
    int i = ilo;
    for (; i + 1 < ihi; i += 2) {
        const int kb = kb0 + 32 * i;
        __builtin_amdgcn_sched_barrier(0);
        load_frags(fb, K0, V0, kb + 32, mode, rsel, lane);
        tile_all<NH>(fa, ql, vst, lane, hi, kb, radius, qa, qb, A, B);
        __builtin_amdgcn_sched_barrier(0);
        load_frags(fa, K0, V0, kb0 + 32 * min(i + 2, ihi - 1), mode, rsel, lane);
        tile_all<NH>(fb, ql, vst, lane, hi, kb + 32, radius, qa, qb, A, B);
    }
    __builtin_amdgcn_sched_barrier(0);
    if (i < ihi) tile_all<NH>(fa, ql, vst, lane, hi, kb0 + 32 * i, radius, qa, qb, A, B);
}
constexpr int OST_RS = 144;
__device__ __forceinline__ void orows_put(const f32x16 (&o)[2], float sc, LAS unsigned char* stg, int lane) {
    const int q = lane & 31, hi = lane >> 5;
#pragma unroll
    for (int dh = 0; dh < 2; ++dh)
#pragma unroll
        for (int g = 0; g < 4; ++g) { u32x2 w; w.x = pk2(o[dh][4 * g] * sc, o[dh][4 * g + 1] * sc); w.y = pk2(o[dh][4 * g + 2] * sc, o[dh][4 * g + 3] * sc);
            *(LAS u32x2*)(stg + q * OST_RS + (32 * dh + 8 * g + 4 * hi) * 2) = w; }
}
__device__ __forceinline__ void orows_store(LAS unsigned char* stg, bf16_t* mix, const ORows& R, int lane) {
#pragma unroll
    for (int i = 0; i < 4; ++i) { const int c = lane + 64 * i, rr = c >> 3, pc = c & 7;
        const u32x4 v = *(const LAS u32x4*)(stg + rr * OST_RS + pc * 16);
        *(u32x4*)(mix + (orow_off(R, rr) + (unsigned)(pc * 8))) = v; }
}
__device__ __forceinline__ void attn_store(const HState& S, bf16_t* mix, const ORows& R, LAS unsigned char* stg, int lane) {
    float l = pg8::sum_x32(S.l);
    orows_put(S.o, 1.0f / l, stg, lane);
    orows_store(stg, mix, R, lane);
}
__device__ __forceinline__ void attn_store_lse(const HState& S, bf16_t* mix, const ORows& R, LAS unsigned char* stg, float* lsep, int lane) {
    float l = pg8::sum_x32(S.l);
    orows_put(S.o, 1.0f / l, stg, lane);
    orows_store(stg, mix, R, lane);
    if ((lane >> 5) == 0) *lsep = S.m + __builtin_amdgcn_logf(l);
}
__device__ __forceinline__ void attn_store_merge(const HState& S, bf16_t* mix, const ORows& R, LAS unsigned char* stg, const float* lsep, int lane) {
    const int q = lane & 31, hi = lane >> 5;
    u32x4 xr[4];
#pragma unroll
    for (int i = 0; i < 4; ++i) { const int c = lane + 64 * i; xr[i] = *(const u32x4*)(mix + (orow_off(R, c >> 3) + (unsigned)((c & 7) * 8))); }
    float l = pg8::sum_x32(S.l);
    const float lx = *lsep, M = fmaxf(S.m, lx), wy = __builtin_amdgcn_exp2f(S.m - M), wx = __builtin_amdgcn_exp2f(lx - M);
    const float inv = 1.0f / (wy * l + wx), ay = wy * inv, ax = wx * inv;
#pragma unroll
    for (int i = 0; i < 4; ++i) { const int c = lane + 64 * i; *(LAS u32x4*)(stg + (c >> 3) * OST_RS + (c & 7) * 16) = xr[i]; }
#pragma unroll
    for (int dh = 0; dh < 2; ++dh)
#pragma unroll
        for (int g = 0; g < 4; ++g) { LAS u32x2* slot = (LAS u32x2*)(stg + q * OST_RS + (32 * dh + 8 * g + 4 * hi) * 2); const u32x2 old = *slot;
            u32x2 w; w.x = pk2(S.o[dh][4 * g] * ay + __uint_as_float(old.x << 16) * ax, S.o[dh][4 * g + 1] * ay + __uint_as_float(old.x & 0xffff0000u) * ax);
            w.y = pk2(S.o[dh][4 * g + 2] * ay + __uint_as_float(old.y << 16) * ax, S.o[dh][4 * g + 3] * ay + __uint_as_float(old.y & 0xffff0000u) * ax);
            *slot = w; }
    orows_store(stg, mix, R, lane);
}
__device__ __forceinline__ void hstate_init(HState& S, float m, float l) {
#pragma unroll
    for (int r = 0; r < 16; ++r) { S.o[0][r] = 0.f; S.o[1][r] = 0.f; }
    S.m = m; S.l = l;
}

__device__ __forceinline__ void attn_even_unit(int uid, const bf16_t* proj, const bf16_t* kd, const bf16_t* vd, bf16_t* mix, const float* sink, int lane, LAS bf16x8* qlds  , LAS unsigned char* vst) {
    asm volatile("v_mbcnt_lo_u32_b32 %0, -1, 0\n\tv_mbcnt_hi_u32_b32 %0, -1, %0" : "=v"(lane));
    const int qt = uid & 127, kvh = (uid >> 7) & 1, b = uid >> 8;
    const int q0 = qt * 32;
    const bf16_t* K0 = kd + (size_t)(b * 2 + kvh) * (4096 * 64);
    const bf16_t* V0 = vd + (size_t)(b * 2 + kvh) * (4096 * 64);
    for (int hp = 0; hp < 2; ++hp) {
        const int h0 = kvh * 4 + hp * 2;
        asm volatile("v_mbcnt_lo_u32_b32 %0, -1, 0\n\tv_mbcnt_hi_u32_b32 %0, -1, %0" : "=v"(lane));
        const int lane31 = lane & 31, hi = lane >> 5, t = q0 + lane31; const QSet qs{t, q0, q0 + 31};
        { u32x4 qa_[4], qb_[4];
          const ORows Ra{(unsigned)(b * SEQ + q0), 1u, 31u, 5u, 1280u, (unsigned)(h0 * 64)}, Rb{(unsigned)(b * SEQ + q0), 1u, 31u, 5u, 1280u, (unsigned)((h0 + 1) * 64)};
          q_rows_load(proj, Ra, lane, qa_); q_rows_load(proj, Rb, lane, qb_);
          q_rows_stage(qa_, (LAS unsigned char*)qlds, lane); q_rows_stage(qb_, (LAS unsigned char*)qlds + QST_SET, lane); }
        HState A, B;
        hstate_init(A, sink[h0] * 1.4426950408889634f, (hi == 0) ? 1.f : 0.f); hstate_init(B, sink[h0 + 1] * 1.4426950408889634f, (hi == 0) ? 1.f : 0.f);
        attn_pass<2>((const LAS unsigned char*)qlds + lane31 * QST_RS + 16 * hi, vst, lane, K0, V0, 0, 0, SEQ, q0 - 128, 9, 128, qs, qs, A, B);
        asm volatile("v_mbcnt_lo_u32_b32 %0, -1, 0\n\tv_mbcnt_hi_u32_b32 %0, -1, %0" : "=v"(lane));
        { const ORows R{(unsigned)(b * SEQ + q0), 1u, 31u, 5u, 1024u, (unsigned)(h0 * 64)}; attn_store(A, mix, R, vst, lane); }
        { const ORows R{(unsigned)(b * SEQ + q0), 1u, 31u, 5u, 1024u, (unsigned)((h0 + 1) * 64)}; attn_store(B, mix, R, vst, lane); }
    }
}
__device__ __forceinline__ void attn_x_unit(int uid, const bf16_t* proj, const bf16_t* kd, const bf16_t* vd, bf16_t* mix, float* lse, int lane, LAS bf16x8* qlds, LAS unsigned char* vst) {
    asm volatile("v_mbcnt_lo_u32_b32 %0, -1, 0\n\tv_mbcnt_hi_u32_b32 %0, -1, %0" : "=v"(lane));
    const int qt = uid & 127, kvh = (uid >> 7) & 3, b = uid >> 9, lane31 = lane & 31, hi = lane >> 5;
    const int q0 = qt * 32, t = q0 + lane31; const size_t row = (size_t)b * SEQ + t;
    const bf16_t* K0 = kd + (size_t)(b * 4 + kvh) * (4096 * 64);
    const bf16_t* V0 = vd + (size_t)(b * 4 + kvh) * (4096 * 64);
    const QSet qs{t, q0, q0 + 31};
    { u32x4 qa_[4], qb_[4];
      const ORows Ra{(unsigned)(b * SEQ + q0), 1u, 31u, 5u, 2048u, (unsigned)((kvh * 2) * 64)}, Rb{(unsigned)(b * SEQ + q0), 1u, 31u, 5u, 2048u, (unsigned)((kvh * 2 + 1) * 64)};
      q_rows_load(proj, Ra, lane, qa_); q_rows_load(proj, Rb, lane, qb_);
      q_rows_stage(qa_, (LAS unsigned char*)qlds, lane); q_rows_stage(qb_, (LAS unsigned char*)qlds + QST_SET, lane); }
    HState A, B; hstate_init(A, -1e30f, 0.f); hstate_init(B, -1e30f, 0.f);
    attn_pass<2>((const LAS unsigned char*)qlds + lane31 * QST_RS + 16 * hi, vst, lane, K0, V0, 2, 0, SEQ, q0 - 64, 5, 64, qs, qs, A, B);
    { const ORows R{(unsigned)(b * SEQ + q0), 1u, 31u, 5u, 512u, (unsigned)((kvh * 2) * 64)}; attn_store_lse(A, mix, R, vst, lse + (size_t)(kvh * 2) * NTOK + row, lane); }
    { const ORows R{(unsigned)(b * SEQ + q0), 1u, 31u, 5u, 512u, (unsigned)((kvh * 2 + 1) * 64)}; attn_store_lse(B, mix, R, vst, lse + (size_t)(kvh * 2 + 1) * NTOK + row, lane); }
}
__device__ __forceinline__ void attn_odd_unit(int uid, const bf16_t* proj, const bf16_t* kd, const bf16_t* vd, bf16_t* mix, const float* lse, int lane, LAS bf16x8* qlds, LAS unsigned char* vst) {
    asm volatile("v_mbcnt_lo_u32_b32 %0, -1, 0\n\tv_mbcnt_hi_u32_b32 %0, -1, %0" : "=v"(lane));
    const int rp = uid & 7, lt = (uid >> 3) & 15, kvh = (uid >> 7) & 3, b = uid >> 9, lane31 = lane & 31, hi = lane >> 5;
    const int rA = (rp & 3) + 8 * (rp >> 2), rB = rA + 4;
    const int j = lane31 >> 4, a = lane31 & 15, l0 = lt * 16, tA = rA + 16 * (l0 + a); const size_t rowA = (size_t)b * SEQ + tA, rowB = rowA + 4;
    HState A, B; hstate_init(A, -1e30f, 0.f); hstate_init(B, -1e30f, 0.f);
    const size_t LAY = (size_t)16 * 256 * 4096;
    const size_t bk = (size_t)(b * 4 + kvh) * (4096 * 64);
#pragma unroll
    for (int g = 1; g < 3; ++g) {
        const int D = (g == 0) ? 1 : (g == 1 ? 4 : 16), s = 16 / D, L = SEQ / D, nt = (g == 0) ? 12 : (g == 1 ? 6 : 5);
        const int head = g * 8 + kvh * 2 + j;
        { u32x4 qa_[4], qb_[4];
          const ORows Ra{(unsigned)(b * SEQ + rA + 16 * l0), 16u, 15u, 4u, 2048u, (unsigned)((g * 8 + kvh * 2) * 64)}, Rb{(unsigned)(b * SEQ + rB + 16 * l0), 16u, 15u, 4u, 2048u, (unsigned)((g * 8 + kvh * 2) * 64)};
          q_rows_load(proj, Ra, lane, qa_); q_rows_load(proj, Rb, lane, qb_);
          q_rows_stage(qa_, (LAS unsigned char*)qlds, lane); q_rows_stage(qb_, (LAS unsigned char*)qlds + QST_SET, lane); }
        const int cA = rA / D, cB = rB / D;
        const QSet qa{cA + s * (l0 + a), cA + s * l0, cA + s * (l0 + 15)}, qb{cB + s * (l0 + a), cB + s * l0, cB + s * (l0 + 15)};
        const int kb0 = (s * l0 - 64) & ~31;
        if (g < 2) {
            attn_pass<2>((const LAS unsigned char*)qlds + lane31 * QST_RS + 16 * hi, vst, lane, kd + bk, vd + bk, 1, rA & 3, L, kb0, nt, 64, qa, qb, A, B);
        } else {
            attn_pass<1>((const LAS unsigned char*)qlds + lane31 * QST_RS + 16 * hi, vst, lane, kd + bk + (size_t)(rA * L) * 64, vd + bk + (size_t)(rA * L) * 64, 0, 0, L, kb0, nt, 64, qa, qa, A, A);
            attn_pass<1>((const LAS unsigned char*)qlds + lane31 * QST_RS + 16 * hi + QST_SET, vst, lane, kd + bk + (size_t)(rB * L) * 64, vd + bk + (size_t)(rB * L) * 64, 0, 0, L, kb0, nt, 64, qb, qb, B, B);
        }
    }
    { const ORows R{(unsigned)(b * SEQ + rA + 16 * l0), 16u, 15u, 4u, 512u, (unsigned)((kvh * 2) * 64)}; attn_store_merge(A, mix, R, vst, lse + (size_t)(kvh * 2 + j) * NTOK + rowA, lane); }
    { const ORows R{(unsigned)(b * SEQ + rB + 16 * l0), 16u, 15u, 4u, 512u, (unsigned)((kvh * 2) * 64)}; attn_store_merge(B, mix, R, vst, lse + (size_t)(kvh * 2 + j) * NTOK + rowB, lane); }
}
__device__ __forceinline__ void bf8_unpack(const u32x4 v, float (&f)[8]) {
#pragma unroll
    for (int i = 0; i < 4; ++i) { f[2 * i] = __uint_as_float(v[i] << 16); f[2 * i + 1] = __uint_as_float(v[i] & 0xffff0000u); }
}
__device__ __forceinline__ void pool_rows32(int row0, const bf16_t* proj, bf16_t* mix, int lane) {
    const int t0 = row0 & 4095, w2 = 1 << (lane >> 4);
    const bf16_t* base = proj + (size_t)(row0 - t0) * 1280 + 768 + 8 * lane;
    float S[8];
#pragma unroll
    for (int i = 0; i < 8; ++i) S[i] = 0.f;
    {
        u32x4 v[16];
#pragma unroll
        for (int k = 0; k < 16; ++k) { const int off = k - 8, tt = t0 + off; const bool ok = (off >= -w2) && (off < w2) && (tt >= 0) && (tt < SEQ);
            v[k] = (u32x4){0u, 0u, 0u, 0u}; if (ok) v[k] = *(const u32x4*)(base + (unsigned)tt * 1280u); }
#pragma unroll
        for (int k = 0; k < 16; ++k) { float f[8]; bf8_unpack(v[k], f);
#pragma unroll
            for (int i = 0; i < 8; ++i) S[i] += f[i]; }
    }
#pragma unroll 1
    for (int rb = 0; rb < 32; rb += 8) {
        u32x4 ve[8], vl[8], vc[8];
#pragma unroll
        for (int r = 0; r < 8; ++r) { const int t = t0 + rb + r, te = t + w2, tl = t - w2;
            vc[r] = *(const u32x4*)(base + (unsigned)t * 1280u);
            ve[r] = (u32x4){0u, 0u, 0u, 0u}; if (te < SEQ) ve[r] = *(const u32x4*)(base + (unsigned)te * 1280u);
            vl[r] = (u32x4){0u, 0u, 0u, 0u}; if (tl >= 0) vl[r] = *(const u32x4*)(base + (unsigned)tl * 1280u); }
#pragma unroll
        for (int r = 0; r < 8; ++r) { const int t = t0 + rb + r, lo = max(t - w2, 0), hi = min(t + w2, SEQ);
            const float inv = 1.0f / (float)(hi - lo);
            float c[8], d[8]; bf8_unpack(vc[r], c);
#pragma unroll
            for (int i = 0; i < 8; ++i) d[i] = S[i] * inv - c[i];
            u32x4 w; w.x = pk2(d[0], d[1]); w.y = pk2(d[2], d[3]); w.z = pk2(d[4], d[5]); w.w = pk2(d[6], d[7]);
            *(u32x4*)(mix + (size_t)(row0 + rb + r) * 1024 + 512 + 8 * lane) = w;
            float e[8], l[8]; bf8_unpack(ve[r], e); bf8_unpack(vl[r], l);
#pragma unroll
            for (int i = 0; i < 8; ++i) S[i] += e[i] - l[i]; }
    }
}

__global__ void __launch_bounds__(NTHREADS, 2) fwd_megakernel(Params p) {
    extern __shared__ __attribute__((aligned(16))) unsigned char lds_raw[];
    cg::grid_group grid = cg::this_grid();
    LAS unsigned char* lds = (LAS unsigned char*)lds_raw;
    const int tid = threadIdx.x, lane = tid & 63, wave = __builtin_amdgcn_readfirstlane(tid >> 6);
    const int G = gridDim.x, bx = blockIdx.x;
    const int gw = bx * NWAVES + wave, NGW = G * NWAVES;
    const int vb = (G % 8 == 0) ? (bx % 8) * (G / 8) + bx / 8 : bx;
    unsigned char* ws = p.ws;
    bf16_t* XB = (bf16_t*)(ws + WS_XB); bf16_t* PROJ = (bf16_t*)(ws + WS_PROJ); bf16_t* VT = (bf16_t*)(ws + WS_VT); bf16_t* MIX = (bf16_t*)(ws + WS_MIX); bf16_t* KD = (bf16_t*)(ws + WS_KD); bf16_t* UB = (bf16_t*)(ws + WS_U);
    float* PART = (float*)(ws + WS_PART); float* LSE = (float*)(ws + WS_LSE); float* CS = (float*)(ws + WS_CS); float* WF = (float*)(ws + WS_WF);

    volatile LAS unsigned* MISC = (volatile LAS unsigned*)(lds + MISC_OFF);
    if (tid < 4) MISC[tid] = 0u;
    unsigned* BAR = (unsigned*)(ws + WS_BAR);
    if (bx == 0) for (int i = tid; i < XCD_BAR_WORDS; i += NTHREADS) BAR[i] = 0u;
    __syncthreads();
#ifndef REP_PRO
#define REP_PRO 1
#endif
    for (int rep_p = 0; rep_p < REP_PRO; ++rep_p)
    {
        const int gt = bx * NTHREADS + tid, NT = G * NTHREADS;
        for (int u = gw; u < 2048; u += NGW) {
            const int nb = u & 15, k8 = (u >> 4) & 15, g = (u >> 8) & 3, e = u >> 10, n = nb * 64 + lane, k0 = k8 * 8;
            const float* wp = p.w_pool + ((size_t)(e * 4 + g) * 128 + k0) * 128; const float* sc = p.pool_scale + e * 512 + g * 128;
            const float* wo = p.w_out_even + ((size_t)e * 1024 + 512 + g * 128) * 1024 + n;
            float acc[8];
#pragma unroll
            for (int i = 0; i < 8; ++i) acc[i] = 0.f;
#pragma unroll 16
            for (int jj = 0; jj < 128; ++jj) { const float w = wo[(size_t)jj * 1024] * sc[jj];
#pragma unroll
                for (int i = 0; i < 8; ++i) acc[i] += wp[i * 128 + jj] * w; }
            u32x4 o; o.x = pk2(acc[0], acc[1]); o.y = pk2(acc[2], acc[3]); o.z = pk2(acc[4], acc[5]); o.w = pk2(acc[6], acc[7]);
            *(u32x4*)((bf16_t*)(ws + WS_WOUT_E) + (size_t)e * 1024 * 1024 + (size_t)n * 1024 + 512 + g * 128 + k0) = o;
        }
        for (int idx = gt; idx < SEQ * 8; idx += NT) {
            const int i = idx & 7, pos = idx >> 3;
            const float inv = (i == 0) ? 1.0f : (i == 1) ? 0.1939227432012558f : (i == 2) ? 0.03760603070259094f : (i == 3) ? 0.007292664609849453f : (i == 4) ? 0.0014142135623842478f : (i == 5) ? 0.00027424818836152554f : (i == 6) ? 5.3182957344688475e-05f : 1.0313385246263351e-05f;
            float c, s; sincos_d((float)pos * inv, c, s);
            CS[pos * 16 + i] = c; CS[pos * 16 + 8 + i] = s;
        }
        {
            LAS float* scr = (LAS float*)(lds + wave * 16384);
            int itbase = 0;
            for (int jb = 0; jb < NJOBS; ++jb) {
                const Job J = get_job(p, jb); const int nitems = (J.Kr / 64) * (J.N / 32);
                const int first = (gw - (itbase % NGW) + NGW) % NGW;
                for (int it = first; it < nitems; it += NGW) transpose_item(J.W, J.g, J.N, J.WT, J.ldk, J.koff, scr, it, lane);
                itbase += nitems;
            }
        }
        for (int r0 = gw * 4; r0 < NTOK; r0 += NGW * 4) {
            f32x4 v[4][4];
#pragma unroll
            for (int q = 0; q < 4; ++q) { const f32x4* xr = (const f32x4*)(p.x + (size_t)(r0 + q) * DM) + lane;
#pragma unroll
                for (int jj = 0; jj < 4; ++jj) v[q][jj] = xr[64 * jj]; }
            float ssq[4];
#pragma unroll
            for (int q = 0; q < 4; ++q) { float ss = 0.f; unsigned long long* o8 = (unsigned long long*)(XB + (size_t)(r0 + q) * DM) + lane;
#pragma unroll
                for (int jj = 0; jj < 4; ++jj) { ss += (v[q][jj][0] * v[q][jj][0] + v[q][jj][1] * v[q][jj][1]) + (v[q][jj][2] * v[q][jj][2] + v[q][jj][3] * v[q][jj][3]);
                    o8[64 * jj] = (unsigned long long)pk2(v[q][jj][0], v[q][jj][1]) | ((unsigned long long)pk2(v[q][jj][2], v[q][jj][3]) << 32); }
                ssq[q] = wave_sum(ss); }
            { const int sl = lane >= 60 ? 0 : 1 + (lane >> 2), qq = lane >= 60 ? lane - 60 : (lane & 3);
              const float val = lane >= 60 ? (qq == 0 ? ssq[0] : qq == 1 ? ssq[1] : qq == 2 ? ssq[2] : ssq[3]) : 0.f;
              PART[(size_t)sl * NTOK + r0 + qq] = val; }
        }
    }
    grid.sync();
    const XcdBarrier xbar = xcd_barrier_post(BAR, MISC, wave);
#define GRID_BAR() xcd_barrier(xbar, wave)
#ifndef XBAR_EXTRA
#define XBAR_EXTRA 0
#endif
    for (int xs = 0; xs < XBAR_EXTRA; ++xs) GRID_BAR();

    for (int layer = 0; layer < 4; ++layer) {
        const int odd = layer & 1, li = layer >> 1;
        {
            const int N = odd ? 2048 : 1280;
            const bf16_t* Wt = odd ? (const bf16_t*)(ws + WS_WIN_O) + (size_t)li * 2048 * 1024 : (const bf16_t*)(ws + WS_WIN_E) + (size_t)li * 1280 * 1024;
            pg8::Gemm g{XB, Wt, NTOK, N, 1024}; pg8::StaticOrder S; S.init(NTOK, N, G, bx);
            pg8::EpiProj E{PROJ, N, PART, CS, VT, KD, odd};
#ifndef REP_IN
#define REP_IN 1
#endif
            for (int rep = 0; rep < REP_IN; ++rep)
            pg8::gemm_phase<pg8::EpiProj, pg8::StaticOrder, true, true>(lds, g, S, E, wave);
        }
        GRID_BAR();
#ifndef REP_ATTN_E
#define REP_ATTN_E 1
#endif
#ifndef REP_ATTN_O
#define REP_ATTN_O 1
#endif
        for (int rep = 0; rep < (odd ? REP_ATTN_O : REP_ATTN_E); ++rep) {
        int lane_o; asm volatile("v_mbcnt_lo_u32_b32 %0, -1, 0\n\tv_mbcnt_hi_u32_b32 %0, -1, %0" : "=v"(lane_o)); const int gwv = vb * NWAVES + wave;
        if (odd) {
#ifndef REP_X
#define REP_X 1
#endif
            for (int rq = 0; rq < REP_X; ++rq)
            for (int uid = gwv; uid < 8192; uid += NGW) attn_x_unit(uid, PROJ, KD, VT, MIX, LSE, lane_o, (LAS bf16x8*)(lds + wave * WAVE_LDS), lds + wave * WAVE_LDS + 2 * QST_SET);
            GRID_BAR();
            int lane_y; asm volatile("v_mbcnt_lo_u32_b32 %0, -1, 0\n\tv_mbcnt_hi_u32_b32 %0, -1, %0" : "=v"(lane_y));
            for (int uid = gwv; uid < 8192; uid += NGW) attn_odd_unit(uid, PROJ, KD, VT, MIX, LSE, lane_y, (LAS bf16x8*)(lds + wave * WAVE_LDS), lds + wave * WAVE_LDS + 2 * QST_SET);
        } else {
#ifndef REP_EATT
#define REP_EATT 1
#endif
#ifndef REP_POOL
#define REP_POOL 1
#endif
            for (int rq = 0; rq < REP_EATT; ++rq)
            for (int uid = gwv; uid < 4096; uid += NGW) attn_even_unit(uid, PROJ, KD, VT, MIX, p.sink + li * 8, lane_o, (LAS bf16x8*)(lds + wave * WAVE_LDS), lds + wave * WAVE_LDS + 2 * QST_SET);
            int lane_p; asm volatile("v_mbcnt_lo_u32_b32 %0, -1, 0\n\tv_mbcnt_hi_u32_b32 %0, -1, %0" : "=v"(lane_p));
            for (int rq = 0; rq < REP_POOL; ++rq)
            for (int r0 = gwv * 32; r0 < NTOK; r0 += NGW * 32) pool_rows32(r0, PROJ, MIX, lane_p);
        }
        }
        GRID_BAR();
        {
            const int K = odd ? 512 : 1024;
            const bf16_t* Wt = odd ? (const bf16_t*)(ws + WS_WOUT_O) + (size_t)li * 1024 * 512 : (const bf16_t*)(ws + WS_WOUT_E) + (size_t)li * 1024 * 1024;
            pg8::Gemm g{MIX, Wt, NTOK, 1024, K}; pg8::StaticOrder S; S.init(NTOK, 1024, G, bx);
#ifndef REP_OUT
#define REP_OUT 0
#endif
            for (int rq = 0; rq < REP_OUT; ++rq) {
                pg8::EpiRes E2{XB, PART, (bf16_t*)(ws + 800 * MiB), (float*)(ws + 930 * MiB)};
                pg8::gemm_phase<pg8::EpiRes, pg8::StaticOrder, true, true>(lds, g, S, E2, wave);
            }
            pg8::EpiRes E{XB, PART, XB, PART};
            pg8::gemm_phase<pg8::EpiRes, pg8::StaticOrder, true, true>(lds, g, S, E, wave);
        }
        GRID_BAR();
        {
            pg8::Gemm g{XB, (const bf16_t*)(ws + WS_WUP) + (size_t)layer * 4096 * 1024, NTOK, 4096, 1024}; pg8::StaticOrder S; S.init(NTOK, 4096, G, bx);
            pg8::EpiUp E{UB, PART};
#ifndef REP_UP
#define REP_UP 1
#endif
            for (int rep = 0; rep < REP_UP; ++rep)
            pg8::gemm_phase<pg8::EpiUp, pg8::StaticOrder, true, true>(lds, g, S, E, wave);
        }
        GRID_BAR();
        {
            pg8::Gemm g{UB, (const bf16_t*)(ws + WS_WDN) + (size_t)layer * 1024 * 4096, NTOK, 1024, 4096}; pg8::StaticOrder S; S.init(NTOK, 1024, G, bx);
#ifndef REP_DOWN
#define REP_DOWN 0
#endif
            for (int rq = 0; rq < REP_DOWN; ++rq) {
                pg8::EpiRes E2{XB, PART, (bf16_t*)(ws + 800 * MiB), (float*)(ws + 930 * MiB)};
                pg8::gemm_phase<pg8::EpiRes, pg8::StaticOrder, true, true>(lds, g, S, E2, wave);
            }
            pg8::EpiRes E{XB, PART, XB, PART};
            pg8::gemm_phase<pg8::EpiRes, pg8::StaticOrder, true, true>(lds, g, S, E, wave);
        }
        GRID_BAR();
    }
#ifndef REP_FINAL
#define REP_FINAL 1
#endif
    for (int rep_f = 0; rep_f < REP_FINAL; ++rep_f) {
    int lane_f; asm volatile("v_mbcnt_lo_u32_b32 %0, -1, 0\n\tv_mbcnt_hi_u32_b32 %0, -1, %0" : "=v"(lane_f)); const int gw_f = gw;
    for (int r0 = gw_f * 4; r0 < NTOK; r0 += NGW * 4) {
        unsigned long long xw[4][4];
        float ps = PART[(size_t)(lane_f & 15) * NTOK + r0 + (lane_f >> 4)];
#pragma unroll
        for (int q = 0; q < 4; ++q) { const unsigned long long* xr = (const unsigned long long*)(XB + (size_t)(r0 + q) * DM) + lane_f;
#pragma unroll
            for (int jj = 0; jj < 4; ++jj) xw[q][jj] = xr[64 * jj]; }
        ps += __builtin_bit_cast(float, __builtin_amdgcn_mov_dpp(__builtin_bit_cast(int, ps), 0xB1, 0xF, 0xF, true));
        ps += __builtin_bit_cast(float, __builtin_amdgcn_mov_dpp(__builtin_bit_cast(int, ps), 0x4E, 0xF, 0xF, true));
        ps += __builtin_bit_cast(float, __builtin_amdgcn_mov_dpp(__builtin_bit_cast(int, ps), 0x124, 0xF, 0xF, true));
        ps += __builtin_bit_cast(float, __builtin_amdgcn_mov_dpp(__builtin_bit_cast(int, ps), 0x128, 0xF, 0xF, true));
        const f32x4* gr = (const f32x4*)p.norm_final + lane_f;
#pragma unroll
        for (int q = 0; q < 4; ++q) {
            const float s = __builtin_bit_cast(float, __builtin_amdgcn_readlane(__builtin_bit_cast(int, ps), 16 * q));
            const float rs = __builtin_amdgcn_rsqf(s * (1.0f / 1024.0f) + 1e-6f);
            f32x4* orow = (f32x4*)(p.out + (size_t)(r0 + q) * DM) + lane_f;
#pragma unroll
            for (int jj = 0; jj < 4; ++jj) { const unsigned long long w = xw[q][jj]; const unsigned lo = (unsigned)w, hi = (unsigned)(w >> 32); const f32x4 gg = gr[64 * jj];
                f32x4 v; v[0] = __uint_as_float(lo << 16); v[1] = __uint_as_float(lo & 0xffff0000u); v[2] = __uint_as_float(hi << 16); v[3] = __uint_as_float(hi & 0xffff0000u);
                __builtin_nontemporal_store(v * rs * gg, &orow[64 * jj]); }
        }
    }
    }
}

extern "C" void kernel_launch(void* const* d_in, const int* in_sizes, int n_in, void* d_out, int out_size, void* d_ws, size_t ws_size, hipStream_t stream) {
    static int grid_blocks = 0;
    if (grid_blocks == 0) {
        if (n_in != 13 || out_size != NTOK * DM || ws_size < WS_END) { fprintf(stderr, "kernel_launch: unexpected shapes (n_in %d out %d ws %zu)\n", n_in, out_size, ws_size); grid_blocks = -1; return; }
        int dev = 0, cus = 0, per_cu = 0;
        hipGetDevice(&dev); hipDeviceGetAttribute(&cus, hipDeviceAttributeMultiprocessorCount, dev);
        hipFuncSetAttribute((const void*)fwd_megakernel, hipFuncAttributeMaxDynamicSharedMemorySize, LDS_ALLOC);
        hipOccupancyMaxActiveBlocksPerMultiprocessor(&per_cu, (const void*)fwd_megakernel, NTHREADS, LDS_ALLOC);
        if (per_cu < 1) per_cu = 1;
        (void)hipGetLastError();
        grid_blocks = cus * per_cu;
    }
    if (grid_blocks < 0) return;
    Params p{};
    p.x = (const float*)d_in[0]; p.norm_mix = (const float*)d_in[1]; p.norm_mlp = (const float*)d_in[2]; p.norm_final = (const float*)d_in[3];
    p.w_in_even = (const float*)d_in[4]; p.w_out_even = (const float*)d_in[5]; p.sink = (const float*)d_in[6]; p.w_pool = (const float*)d_in[7]; p.pool_scale = (const float*)d_in[8];
    p.w_in_odd = (const float*)d_in[9]; p.w_out_odd = (const float*)d_in[10]; p.w_up = (const float*)d_in[11]; p.w_down = (const float*)d_in[12];
    p.out = (float*)d_out; p.ws = (unsigned char*)d_ws;
    void* args[] = {&p};
    hipError_t e = hipLaunchCooperativeKernel((const void*)fwd_megakernel, dim3(grid_blocks), dim3(NTHREADS), args, LDS_ALLOC, stream);
    if (e != hipSuccess) fprintf(stderr, "cooperative launch failed: %s (grid %d)\n", hipGetErrorString(e), grid_blocks);
}
```

```cpp
#include <hip/hip_runtime.h>
#include <hip/hip_cooperative_groups.h>
#include <cstdio>
#include <cstdint>
namespace cg = cooperative_groups;
namespace pg8 {
#define PG8_LAS __attribute__((address_space(3)))
typedef unsigned short bf16_t;
typedef short bf16x8 __attribute__((ext_vector_type(8)));
typedef float f32x4 __attribute__((ext_vector_type(4)));
typedef unsigned u32x4 __attribute__((ext_vector_type(4)));
constexpr int BM = 256, BK = 64, HALF = 128, HTB = HALF * BK * 2  , STAGE_BYTES = 8 * HTB, NXCD = 8, WGM = 8;

__host__ __device__ __forceinline__ int lds_byte(int r, int c) { const int st = (r >> 4) * 2 + (c >> 5), rr = r & 15, cc = c & 31, ob = rr * 64 + cc * 2; return st * 1024 + (ob ^ (((ob >> 9) & 1) << 5)); }
__host__ __device__ __forceinline__ void stage_rc(int b, int& R, int& C) { const int st = b / 1024, sb = b % 1024, swz = sb ^ (((sb >> 9) & 1) << 5); R = (st >> 1) * 16 + swz / 64; C = (st & 1) * 32 + (swz % 64) / 2; }
__host__ __device__ __forceinline__ int perm32(int rho) { const int n = rho >> 4, i = rho & 15; return 8 * (i >> 2) + 4 * n + (i & 3); }

struct Unit { int pm, pn; };
struct Gemm { const bf16_t* A; const bf16_t* Bt; int M, N, K; };

struct StaticOrder {
    int nM, nN, nwg, G, c, rev;
    __host__ __device__ void init(int M, int N, int G_, int c_, int rev_ = 0) { nM = M / BM; nN = N / BM; nwg = nM * nN; G = G_; c = c_; rev = rev_; }
    __host__ __device__ bool next(int i, Unit& u) const {
        const long L = (long)i * G + c; if (L >= nwg) return false;
        int wgid = (int)L; { const int q = nwg / NXCD, r = nwg % NXCD, xcd = wgid % NXCD, off = wgid / NXCD; wgid = (xcd < r ? xcd * (q + 1) : r * (q + 1) + (xcd - r) * q) + off; }
        const int nig = WGM * nN, gid = wgid / nig, fm = gid * WGM, gsz = (nM - fm) < WGM ? (nM - fm) : WGM;
        u.pm = fm + ((wgid % nig) % gsz); u.pn = (wgid % nig) / gsz;
        if (rev && nM % NXCD == 0) { const int cs = nM / NXCD; u.pm = (u.pm / cs) * cs + (cs - 1 - u.pm % cs); }
        return true;
    }
    __device__ __forceinline__ void a_ready(const Unit&) const {}
    __device__ __forceinline__ void done(const Unit&) const {}
};

__device__ __forceinline__ unsigned cvt_pk_bf16(float lo, float hi) { unsigned r; asm volatile("v_cvt_pk_bf16_f32 %0, %1, %2" : "=v"(r) : "v"(lo), "v"(hi)); return r; }
__device__ __forceinline__ float sum_x16(float s) { auto r = __builtin_amdgcn_permlane16_swap(__float_as_uint(s), __float_as_uint(s), false, false); return __uint_as_float(r[0]) + __uint_as_float(r[1]); }
__device__ __forceinline__ float sum_x32(float s) { auto r = __builtin_amdgcn_permlane32_swap(__float_as_uint(s), __float_as_uint(s), false, false); return __uint_as_float(r[0]) + __uint_as_float(r[1]); }
__device__ __forceinline__ float peer_x16(float v, int fq) { auto r = __builtin_amdgcn_permlane16_swap(__float_as_uint(v), __float_as_uint(v), false, false); return __uint_as_float((fq & 1) ? r[0] : r[1]); }
constexpr float C2Q = 0.125f * 1.4426950408889634f;
__device__ __forceinline__ float row_rstd(const float* part, int row, int fq) {
    const float* pp = part + (size_t)(4 * fq) * 65536 + row; const f32x4 p = {pp[0], pp[65536], pp[2 * 65536], pp[3 * 65536]};
    float s = (p[0] + p[1]) + (p[2] + p[3]);
    s = sum_x16(s); s = sum_x32(s);
    return __builtin_amdgcn_rsqf(s * (1.0f / 1024.0f) + 1e-6f);
}
__device__ __forceinline__ void rows_part_load(const float* part, int row0  , int fq, f32x4 (&pl)[2][4]) {
#pragma unroll
    for (int ai = 0; ai < 2; ++ai)
#pragma unroll
        for (int m = 0; m < 4; ++m) { const float* pp = part + (size_t)(4 * fq) * 65536 + (row0 + ai * HALF + m * 16);
            pl[ai][m] = (f32x4){pp[0], pp[65536], pp[2 * 65536], pp[3 * 65536]}; }
}
__device__ __forceinline__ void rows_part_reduce(const f32x4 (&pl)[2][4], float (&rs)[2][4]) {
#pragma unroll
    for (int ai = 0; ai < 2; ++ai)
#pragma unroll
        for (int m = 0; m < 4; ++m) { float s = (pl[ai][m][0] + pl[ai][m][1]) + (pl[ai][m][2] + pl[ai][m][3]); s = sum_x16(s); s = sum_x32(s); rs[ai][m] = __builtin_amdgcn_rsqf(s * (1.0f / 1024.0f) + 1e-6f); }
}
__device__ __forceinline__ void rows_rstd(const float* part, int row0, int fq, float (&rs)[2][4]) { f32x4 pl[2][4]; rows_part_load(part, row0, fq, pl); rows_part_reduce(pl, rs); }
struct EpiProj {
    static constexpr bool PERM = true, AFTER_DRAIN = false, NEEDS_RSTD = true;
    bf16_t* proj; int ldp; const float* part; const float* cs; bf16_t* vt; bf16_t* kd; int odd;
    __device__ __forceinline__ void operator()(const f32x4 (&acc)[2][2][4][2], const Unit& u, int wr, int wc, int fr, int fq, PG8_LAS float* stash, int par, PG8_LAS unsigned char* stg, const Unit& un) const {
        const bool newpm = (un.pm != u.pm);
        f32x4 pln[2][4]; if (newpm) rows_part_load(part, un.pm * BM + wr * 64 + fr, fq, pln);
        float rsa[2][4];
#pragma unroll
        for (int ai = 0; ai < 2; ++ai)
#pragma unroll
            for (int m = 0; m < 4; ++m) rsa[ai][m] = stash[par * 256 + ai * HALF + wr * 64 + m * 16 + fr];
#pragma unroll
        for (int ai = 0; ai < 2; ++ai)
#pragma unroll
            for (int m = 0; m < 4; ++m) {
                if (m == 0) asm volatile("" ::: "memory");
                const int row = u.pm * BM + ai * HALF + wr * 64 + m * 16 + fr, pos = row & 4095, b = row >> 12;
                const float rs = rsa[ai][m];
#pragma unroll
                for (int bj = 0; bj < 2; ++bj) {
                    int kind;
                    if (odd) kind = (u.pn < 6) ? 0 : (u.pn == 6 ? 1 : 2);
                    else     kind = (u.pn < 2) ? 0 : (u.pn == 2 ? (wc < 2 ? 1 : 2) : 3);
                    float v[8];
#pragma unroll
                    for (int i = 0; i < 4; ++i) { v[i] = acc[ai][bj][m][0][i] * rs; v[4 + i] = acc[ai][bj][m][1][i] * rs; }
                    if (kind <= 1 && bj == 0) {
                        const f32x4 c0 = *(const f32x4*)(cs + pos * 16), c1 = *(const f32x4*)(cs + pos * 16 + 4), s0 = *(const f32x4*)(cs + pos * 16 + 8), s1 = *(const f32x4*)(cs + pos * 16 + 12);
#pragma unroll
                        for (int i = 0; i < 8; ++i) {
                            const float c = i < 4 ? c0[i & 3] : c1[i & 3], s = i < 4 ? s0[i & 3] : s1[i & 3];
                            const float pr = peer_x16(v[i], fq);
                            const float r = (fq == 0) ? (v[i] * c - pr * s) : (v[i] * c + pr * s);
                            v[i] = (fq < 2) ? r : v[i];
                        }
                    }
                    if (kind == 0) {
#pragma unroll
                        for (int i = 0; i < 8; ++i) v[i] *= C2Q;
                    }
                    { u32x4 w; w.x = cvt_pk_bf16(v[0], v[1]); w.y = cvt_pk_bf16(v[2], v[3]); w.z = cvt_pk_bf16(v[4], v[5]); w.w = cvt_pk_bf16(v[6], v[7]);
                      *(PG8_LAS u32x4*)(stg + fr * 144 + fq * 16 + bj * 64) = w; }
                }
                {
                    int kind;
                    if (odd) kind = (u.pn < 6) ? 0 : (u.pn == 6 ? 1 : 2);
                    else     kind = (u.pn < 2) ? 0 : (u.pn == 2 ? (wc < 2 ? 1 : 2) : 3);
#pragma unroll
                    for (int i = 0; i < 2; ++i) { const int c = fq * 16 + fr + 64 * i, rr = c >> 3, pc = c & 7;
                        const u32x4 w = *(const PG8_LAS u32x4*)(stg + rr * 144 + pc * 16);
                        const int rowc = row - fr + rr, posc = rowc & 4095;
                        if (kind == 1 || kind == 2) {
                            bf16_t* dst = (kind == 1) ? kd : vt;
                            if (odd) *(u32x4*)(dst + (size_t)(b * 4 + wc) * (4096 * 64) + (size_t)((posc & 15) * 256 + (posc >> 4)) * 64 + pc * 8) = w;
                            else     *(u32x4*)(dst + (size_t)(b * 2 + (wc & 1)) * (4096 * 64) + (size_t)posc * 64 + pc * 8) = w;
                        } else {
                            *(u32x4*)(proj + (size_t)rowc * ldp + u.pn * BM + wc * 64 + pc * 8) = w;
                        }
                    }
                }
            }
        if (newpm) { float rsn[2][4]; rows_part_reduce(pln, rsn);
          if (fq == 0) {
#pragma unroll
              for (int ai = 0; ai < 2; ++ai)
#pragma unroll
                  for (int m = 0; m < 4; ++m) stash[(par ^ 1) * 256 + ai * HALF + wr * 64 + m * 16 + fr] = rsn[ai][m]; } }
    }
};
struct EpiRes {
    static constexpr bool PERM = true, AFTER_DRAIN = false, NEEDS_RSTD = false;
    bf16_t* xb; float* part; bf16_t* xo_; float* po_;
    __device__ __forceinline__ void operator()(const f32x4 (&acc)[2][2][4][2], const Unit& u, int wr, int wc, int fr, int fq, PG8_LAS unsigned char* stg) const {
        const int lane = fq * 16 + fr;
        const size_t colw = (size_t)u.pn * BM + wc * 64;
        const int rowb = u.pm * BM + wr * 64;
        PG8_LAS unsigned char* st = stg + fr * 144 + fq * 16;
#pragma unroll
        for (int ai = 0; ai < 2; ++ai) {
        asm volatile("" ::: "memory");
        u32x4 xin[4][2];
#pragma unroll
        for (int m = 0; m < 4; ++m)
#pragma unroll
            for (int i = 0; i < 2; ++i) { const int c = lane + 64 * i; xin[m][i] = *(const u32x4*)(xb + (size_t)(rowb + ai * HALF + m * 16 + (c >> 3)) * 1024 + colw + (c & 7) * 8); }
#pragma unroll
        for (int m = 0; m < 4; ++m) {
            const int row = rowb + ai * HALF + m * 16 + fr;
#pragma unroll
            for (int i = 0; i < 2; ++i) { const int c = lane + 64 * i; *(PG8_LAS u32x4*)(stg + (c >> 3) * 144 + (c & 7) * 16) = xin[m][i]; }
            float ss = 0.f;
#pragma unroll
            for (int bj = 0; bj < 2; ++bj) {
                const u32x4 xo = *(const PG8_LAS u32x4*)(st + bj * 64);
                float v[8];
#pragma unroll
                for (int i = 0; i < 4; ++i) { v[2 * i] = __uint_as_float(xo[i] << 16) + acc[ai][bj][m][i >> 1][(2 * i) & 3]; v[2 * i + 1] = __uint_as_float(xo[i] & 0xffff0000u) + acc[ai][bj][m][i >> 1][(2 * i + 1) & 3]; }
                u32x4 w; w.x = cvt_pk_bf16(v[0], v[1]); w.y = cvt_pk_bf16(v[2], v[3]); w.z = cvt_pk_bf16(v[4], v[5]); w.w = cvt_pk_bf16(v[6], v[7]);
                *(PG8_LAS u32x4*)(st + bj * 64) = w;
                ss += ((v[0] * v[0] + v[1] * v[1]) + (v[2] * v[2] + v[3] * v[3])) + ((v[4] * v[4] + v[5] * v[5]) + (v[6] * v[6] + v[7] * v[7]));
            }
#pragma unroll
            for (int i = 0; i < 2; ++i) { const int c = lane + 64 * i; const u32x4 w = *(const PG8_LAS u32x4*)(stg + (c >> 3) * 144 + (c & 7) * 16);
                *(u32x4*)(xo_ + (size_t)(row - fr + (c >> 3)) * 1024 + colw + (c & 7) * 8) = w; }
            ss = sum_x16(ss); ss = sum_x32(ss);
            if (fq == 0) po_[(size_t)(u.pn * 4 + wc) * 65536 + row] = ss;
        }
        }
    }
};
struct EpiUp {
    static constexpr bool PERM = true, AFTER_DRAIN = false, NEEDS_RSTD = true;
    bf16_t* uo; const float* part;
    __device__ __forceinline__ void operator()(const f32x4 (&acc)[2][2][4][2], const Unit& u, int wr, int wc, int fr, int fq, PG8_LAS float* stash, int par, PG8_LAS unsigned char* stg, const Unit& un) const {
        const bool newpm = (un.pm != u.pm);
        f32x4 pln[2][4]; if (newpm) rows_part_load(part, un.pm * BM + wr * 64 + fr, fq, pln);
        float rsa[2][4];
#pragma unroll
        for (int ai = 0; ai < 2; ++ai)
#pragma unroll
            for (int m = 0; m < 4; ++m) rsa[ai][m] = stash[par * 256 + ai * HALF + wr * 64 + m * 16 + fr];
#pragma unroll
        for (int ai = 0; ai < 2; ++ai)
#pragma unroll
            for (int m = 0; m < 4; ++m) {
                const int row = u.pm * BM + ai * HALF + wr * 64 + m * 16 + fr;
                const float rs = rsa[ai][m];
                PG8_LAS unsigned char* st = stg + fr * 144 + fq * 16;
#pragma unroll
                for (int bj = 0; bj < 2; ++bj) {
                    float v[8];
#pragma unroll
                    for (int i = 0; i < 4; ++i) { v[i] = acc[ai][bj][m][0][i] * rs; v[4 + i] = acc[ai][bj][m][1][i] * rs; }
#pragma unroll
                    for (int i = 0; i < 8; ++i) { const float r = fmaxf(v[i], 0.f); v[i] = r * r; }
                    u32x4 w; w.x = cvt_pk_bf16(v[0], v[1]); w.y = cvt_pk_bf16(v[2], v[3]); w.z = cvt_pk_bf16(v[4], v[5]); w.w = cvt_pk_bf16(v[6], v[7]);
                    *(PG8_LAS u32x4*)(st + bj * 64) = w;
                }
#pragma unroll
                for (int i = 0; i < 2; ++i) { const int c = fq * 16 + fr + 64 * i, rr = c >> 3, pc = c & 7;
                    const u32x4 w = *(const PG8_LAS u32x4*)(stg + rr * 144 + pc * 16);
                    *(u32x4*)(uo + (size_t)(row - fr + rr) * 4096 + u.pn * BM + wc * 64 + pc * 8) = w; }
            }
        if (newpm) { float rsn[2][4]; rows_part_reduce(pln, rsn);
          if (fq == 0) {
#pragma unroll
              for (int ai = 0; ai < 2; ++ai)
#pragma unroll
                  for (int m = 0; m < 4; ++m) stash[(par ^ 1) * 256 + ai * HALF + wr * 64 + m * 16 + fr] = rsn[ai][m]; } }
    }
};
template <class Epi, class Sched, bool ALIGN_EPI = false, bool SP2 = false>
__device__ __forceinline__ void gemm_phase(PG8_LAS unsigned char* lds, const Gemm g, const Sched& S, const Epi& E, const int wave_s) {
    int tid_o; asm volatile("v_mbcnt_lo_u32_b32 %0, -1, 0\n\tv_mbcnt_hi_u32_b32 %0, -1, %0" : "=v"(tid_o)); tid_o += wave_s * 64;
    const int tid = tid_o, wid = __builtin_amdgcn_readfirstlane(tid >> 6), lane = tid & 63, wr = wid >> 2, wc = wid & 3, fr = lane & 15, fq = lane >> 4;
    const int K = g.K, nt = K / BK;
    unsigned voffA[2], voffB[2];
#pragma unroll
    for (int i = 0; i < 2; ++i) { int R, C; stage_rc(tid * 16 + i * 8192, R, C); const int Rb = Epi::PERM ? ((R >> 5) * 64 + perm32(R & 31)) : R;
        voffA[i] = (unsigned)(R * K + C) * 2u; voffB[i] = (unsigned)(Rb * K + C) * 2u; }
    const size_t kstep = (size_t)(BK * 2);
    const size_t hstep = (size_t)HALF * K * 2;
    const size_t bhstep = Epi::PERM ? (size_t)32 * K * 2 : hstep;
    const size_t tstep = 2 * hstep;
    const unsigned ldsw = (unsigned)wid * 1024u;
    const int aoff = lds_byte(wr * 64 + fr, fq * 8), boff = lds_byte(wc * 32 + fr, fq * 8);
#define PG8_SA(b, h) (((b) * 2 + (h)) * HTB)
#define PG8_SB(b, h) ((4 + (b) * 2 + (h)) * HTB)
#define PG8_STAGE(bufoff, gbase, voff) do { _Pragma("unroll") for (int _i = 0; _i < 2; ++_i) \
        __builtin_amdgcn_global_load_lds((const unsigned*)((const char*)(gbase) + (voff)[_i]), (PG8_LAS unsigned*)(lds + (bufoff) + ldsw + _i * 8192), 16, 0, 0); } while (0)
#define PG8_LDA(dst, b, h) do { _Pragma("unroll") for (int m = 0; m < 4; ++m) _Pragma("unroll") for (int k = 0; k < 2; ++k) dst[m][k] = *(const PG8_LAS bf16x8*)(lds + PG8_SA(b, h) + aoff + m * 2048 + k * 1024); } while (0)
#define PG8_LDB(dst, b, h) do { _Pragma("unroll") for (int n = 0; n < 2; ++n) _Pragma("unroll") for (int k = 0; k < 2; ++k) dst[n][k] = *(const PG8_LAS bf16x8*)(lds + PG8_SB(b, h) + boff + n * 2048 + k * 1024); } while (0)
#define PG8_MMA(ai, bj, At, Bt) do { __builtin_amdgcn_s_setprio(1); _Pragma("unroll") for (int m = 0; m < 4; ++m) _Pragma("unroll") for (int n = 0; n < 2; ++n) _Pragma("unroll") for (int k = 0; k < 2; ++k) \
        acc[ai][bj][m][n] = __builtin_amdgcn_mfma_f32_16x16x32_bf16(Bt[n][k], At[m][k], acc[ai][bj][m][n], 0, 0, 0); __builtin_amdgcn_s_setprio(0); } while (0)
#define PG8_WAIT_V(n) asm volatile("s_waitcnt vmcnt(" #n ")" ::: "memory")
#define PG8_WAIT_L(n) asm volatile("s_waitcnt lgkmcnt(" #n ")" ::: "memory")
#define PG8_BAR __builtin_amdgcn_s_barrier()
#define PG8_SCHED __builtin_amdgcn_sched_barrier(0)
    Unit cur, nxt; int ui = 0;
    if (!S.next(0, cur)) return;
    PG8_LAS float* rs_stash = (PG8_LAS float*)(lds + STAGE_BYTES); int rs_par = 0;
    if constexpr (Epi::NEEDS_RSTD) { float rs0[2][4]; rows_rstd(E.part, cur.pm * BM + wr * 64 + fr, fq, rs0);
        if (fq == 0) {
#pragma unroll
            for (int ai = 0; ai < 2; ++ai)
#pragma unroll
                for (int m = 0; m < 4; ++m) rs_stash[ai * HALF + wr * 64 + m * 16 + fr] = rs0[ai][m]; } }
    f32x4 acc[2][2][4][2];
#pragma unroll
    for (int a = 0; a < 2; ++a)
#pragma unroll
        for (int b = 0; b < 2; ++b)
#pragma unroll
            for (int m = 0; m < 4; ++m)
#pragma unroll
                for (int n = 0; n < 2; ++n) acc[a][b][m][n] = (f32x4){0.f, 0.f, 0.f, 0.f};
    bf16x8 At[4][2], B0[2][2], B1[2][2];
    const char* cA = (const char*)g.A + (size_t)cur.pm * tstep; const char* cB = (const char*)g.Bt + (size_t)cur.pn * tstep;
    S.a_ready(cur);
    if constexpr (SP2) {
        PG8_STAGE(PG8_SB(0, 0), cB, voffB); PG8_STAGE(PG8_SB(0, 1), cB + bhstep, voffB); PG8_STAGE(PG8_SA(0, 0), cA, voffA); PG8_STAGE(PG8_SA(0, 1), cA + hstep, voffA);
        if (wr == 1) PG8_BAR;
        PG8_WAIT_V(2); PG8_BAR;
        PG8_STAGE(PG8_SB(1, 0), cB + kstep, voffB); PG8_STAGE(PG8_SA(1, 0), cA + kstep, voffA); PG8_STAGE(PG8_SB(1, 1), cB + bhstep + kstep, voffB);
        PG8_WAIT_V(6); PG8_BAR;
    } else {
        PG8_STAGE(PG8_SB(0, 0), cB, voffB); PG8_STAGE(PG8_SA(0, 0), cA, voffA); PG8_STAGE(PG8_SB(0, 1), cB + bhstep, voffB); PG8_STAGE(PG8_SA(0, 1), cA + hstep, voffA);
        if (wr == 1) PG8_BAR;
        PG8_WAIT_V(4); PG8_BAR;
        PG8_STAGE(PG8_SB(1, 0), cB + kstep, voffB); PG8_STAGE(PG8_SA(1, 0), cA + kstep, voffA); PG8_STAGE(PG8_SB(1, 1), cB + bhstep + kstep, voffB);
        PG8_WAIT_V(6); PG8_BAR;
    }
    for (;;) {
        const bool has_next = S.next(ui + 1, nxt);
        const char* nA = has_next ? (const char*)g.A + (size_t)nxt.pm * tstep : cA; const char* nB = has_next ? (const char*)g.Bt + (size_t)nxt.pn * tstep : cB;
        for (int t = 0; t < nt; t += 2) {
            const bool last = (t == nt - 2);
            const char* a1 = cA + (size_t)(t + 1) * kstep;
            const char* a2 = last ? nA : cA + (size_t)(t + 2) * kstep; const char* b2 = last ? nB : cB + (size_t)(t + 2) * kstep;
            const char* a3 = a2 + kstep; const char* b3 = b2 + kstep;
            if (last && has_next) S.a_ready(nxt);
            if constexpr (SP2) {
            PG8_LDB(B0, 0, 0); PG8_LDB(B1, 0, 1); PG8_SCHED; PG8_LDA(At, 0, 0); PG8_STAGE(PG8_SA(1, 1), a1 + hstep, voffA);
            PG8_WAIT_V(8); PG8_WAIT_L(0); PG8_BAR; PG8_MMA(0, 0, At, B0); PG8_MMA(0, 1, At, B1); PG8_BAR; PG8_SCHED;
            PG8_LDA(At, 0, 1); PG8_STAGE(PG8_SB(0, 0), b2, voffB); PG8_STAGE(PG8_SB(0, 1), b2 + bhstep, voffB); PG8_STAGE(PG8_SA(0, 0), a2, voffA);
            PG8_WAIT_V(8); PG8_WAIT_L(0); PG8_BAR; PG8_MMA(1, 0, At, B0); PG8_MMA(1, 1, At, B1); PG8_BAR; PG8_SCHED;
            PG8_LDB(B0, 1, 0); PG8_LDB(B1, 1, 1); PG8_SCHED; PG8_LDA(At, 1, 0); PG8_STAGE(PG8_SA(0, 1), a2 + hstep, voffA);
            PG8_WAIT_V(8); PG8_WAIT_L(0); PG8_BAR; PG8_MMA(0, 0, At, B0); PG8_MMA(0, 1, At, B1); PG8_BAR; PG8_SCHED;
            PG8_LDA(At, 1, 1); PG8_STAGE(PG8_SB(1, 0), b3, voffB); PG8_STAGE(PG8_SB(1, 1), b3 + bhstep, voffB); PG8_STAGE(PG8_SA(1, 0), a3, voffA);
            PG8_WAIT_V(8); PG8_WAIT_L(0); PG8_BAR; PG8_MMA(1, 0, At, B0); PG8_MMA(1, 1, At, B1); PG8_BAR; PG8_SCHED;
            } else {
            PG8_LDB(B0, 0, 0); PG8_SCHED; PG8_LDA(At, 0, 0); PG8_STAGE(PG8_SA(1, 1), a1 + hstep, voffA);
            PG8_WAIT_L(8); PG8_BAR; PG8_WAIT_L(0); PG8_MMA(0, 0, At, B0); PG8_BAR; PG8_SCHED;
            PG8_LDB(B1, 0, 1); PG8_STAGE(PG8_SB(0, 0), b2, voffB);
            PG8_BAR; PG8_WAIT_L(0); PG8_MMA(0, 1, At, B1); PG8_BAR;
            PG8_LDA(At, 0, 1); PG8_STAGE(PG8_SA(0, 0), a2, voffA);
            PG8_BAR; PG8_WAIT_L(0); PG8_MMA(1, 0, At, B0); PG8_BAR; PG8_SCHED;
            PG8_STAGE(PG8_SB(0, 1), b2 + bhstep, voffB);
            PG8_WAIT_V(6); PG8_BAR; PG8_MMA(1, 1, At, B1); PG8_BAR;
            PG8_LDB(B0, 1, 0); PG8_SCHED; PG8_LDA(At, 1, 0); PG8_STAGE(PG8_SA(0, 1), a2 + hstep, voffA);
            PG8_WAIT_L(8); PG8_BAR; PG8_WAIT_L(0); PG8_MMA(0, 0, At, B0); PG8_BAR; PG8_SCHED;
            PG8_LDB(B1, 1, 1); PG8_STAGE(PG8_SB(1, 0), b3, voffB);
            PG8_BAR; PG8_WAIT_L(0); PG8_MMA(0, 1, At, B1); PG8_BAR;
            PG8_LDA(At, 1, 1); PG8_STAGE(PG8_SA(1, 0), a3, voffA);
            PG8_BAR; PG8_WAIT_L(0); PG8_MMA(1, 0, At, B0); PG8_BAR; PG8_SCHED;
            PG8_STAGE(PG8_SB(1, 1), b3 + bhstep, voffB);
            PG8_WAIT_V(6); PG8_BAR; PG8_MMA(1, 1, At, B1); PG8_BAR;
            }
        }
        if constexpr (ALIGN_EPI) { if (wr == 0) PG8_BAR; }
        if constexpr (!Epi::AFTER_DRAIN) { if constexpr (Epi::NEEDS_RSTD) E(acc, cur, wr, wc, fr, fq, rs_stash, rs_par, (PG8_LAS unsigned char*)(lds + STAGE_BYTES + 2048 + wid * 2304), has_next ? nxt : cur); else E(acc, cur, wr, wc, fr, fq, (PG8_LAS unsigned char*)(lds + STAGE_BYTES + 2048 + wid * 2304)); S.done(cur); }
        if (!has_next) break;
#pragma unroll
        for (int a = 0; a < 2; ++a)
#pragma unroll
            for (int b = 0; b < 2; ++b)
#pragma unroll
                for (int m = 0; m < 4; ++m)
#pragma unroll
                    for (int n = 0; n < 2; ++n) acc[a][b][m][n] = (f32x4){0.f, 0.f, 0.f, 0.f};
        if (nxt.pm != cur.pm) rs_par ^= 1;
        cur = nxt; cA = nA; cB = nB; ++ui;
        if constexpr (ALIGN_EPI) { if (wr == 1) PG8_BAR; }
    }
    PG8_WAIT_V(0);
    if constexpr (!ALIGN_EPI) { if (wr == 0) PG8_BAR; }
    PG8_BAR;
    if constexpr (Epi::AFTER_DRAIN) { E.fused(acc, cur, wr, wc, fr, fq, lds, wid, lane); S.done(cur); }
#undef PG8_SA
#undef PG8_SB
#undef PG8_STAGE
#undef PG8_LDA
#undef PG8_LDB
#undef PG8_MMA
#undef PG8_WAIT_V
#undef PG8_WAIT_L
#undef PG8_BAR
#undef PG8_SCHED
}
}
#define LAS __attribute__((address_space(3)))
typedef pg8::bf16_t bf16_t;
typedef short bf16x8 __attribute__((ext_vector_type(8)));
typedef float f32x4 __attribute__((ext_vector_type(4)));
typedef float f32x16 __attribute__((ext_vector_type(16)));
typedef unsigned u32x4 __attribute__((ext_vector_type(4)));
typedef unsigned u32x2 __attribute__((ext_vector_type(2)));

constexpr int NTOK = 65536, DM = 1024, SEQ = 4096, NB = 16, DFF = 4096;
constexpr int NWAVES = 8, NTHREADS = 512;
constexpr int LDS_BYTES = 131072, LDS_ALLOC = 163840, WAVE_LDS = 20480, MISC_OFF = LDS_ALLOC - 256;
constexpr size_t MiB = (size_t)1 << 20;
constexpr size_t WS_WIN_E = 0, WS_WOUT_E = 5 * MiB, WS_WIN_O = 9 * MiB, WS_WOUT_O = 17 * MiB, WS_WUP = 19 * MiB, WS_WDN = 51 * MiB;
constexpr size_t WS_WF = 83 * MiB, WS_CS = 87 * MiB, WS_PART = 88 * MiB, WS_BAR = 92 * MiB, WS_LSE = 93 * MiB, WS_XB = 96 * MiB, WS_BIG = 224 * MiB;
constexpr size_t WS_PROJ = WS_BIG, WS_VT = WS_BIG + 256 * MiB, WS_MIX = WS_BIG + 352 * MiB, WS_KD = WS_BIG + 480 * MiB, WS_U = WS_BIG, WS_END = WS_BIG + 576 * MiB;

struct Params {
    const float *x, *norm_mix, *norm_mlp, *norm_final, *w_in_even, *w_out_even, *sink, *w_pool, *pool_scale, *w_in_odd, *w_out_odd, *w_up, *w_down;
    float* out; unsigned char* ws;
};

__device__ __forceinline__ unsigned pk2(float lo, float hi) { return pg8::cvt_pk_bf16(lo, hi); }
__device__ __forceinline__ float wave_sum(float v) {
#pragma unroll
    for (int o = 1; o < 64; o <<= 1) v += __shfl_xor(v, o);
    return v;
}

#define XB_TMO      128
#define XB_XCNT(j)  (256  + 64 * (j))
#define XB_XSUB(j)  (1280 + 64 * (j))
#define XB_XGEN(j)  (2304 + 64 * (j))
#define XB_TOP      3328
#define XB_TOPGEN   3392
#define XCD_BAR_WORDS 3456
#define XB_SPIN_CAP (1u << 22)
__device__ __forceinline__ unsigned xb_ld(unsigned* p)              { return __hip_atomic_load(p, __ATOMIC_RELAXED, __HIP_MEMORY_SCOPE_AGENT); }
__device__ __forceinline__ unsigned xb_add(unsigned* p, unsigned v) { return __hip_atomic_fetch_add(p, v, __ATOMIC_RELAXED, __HIP_MEMORY_SCOPE_AGENT); }
__device__ __forceinline__ unsigned xb_xcc_id() { return (unsigned)__builtin_amdgcn_s_getreg((3 << 11) | 20) & 0xFu; }
#define XB_SPIN(cond, bar) do { unsigned _sp = 0; while (cond) { __builtin_amdgcn_s_sleep(1); \
    if ((++_sp & 255u) == 0u) { if (xb_ld(&(bar)[XB_TMO])) break; if (_sp > XB_SPIN_CAP) { atomicAdd(&(bar)[XB_TMO], 1u); break; } } } } while (0)
struct XcdBarrier { unsigned* bar; unsigned x; volatile LAS unsigned* st; };
__device__ __forceinline__ bool wg_leader(int wave) { int ln; asm volatile("v_mbcnt_lo_u32_b32 %0, -1, 0\n\tv_mbcnt_hi_u32_b32 %0, -1, %0" : "=v"(ln)); return wave == 0 && ln == 0; }
__device__ __forceinline__ XcdBarrier xcd_barrier_post(unsigned* bar, volatile LAS unsigned* st, int wave) {
    XcdBarrier b; b.bar = bar; b.x = xb_xcc_id(); b.st = st;
    if (wg_leader(wave)) (void)xb_add(&bar[XB_XCNT(b.x)], 1u);
    return b;
}
__device__ __forceinline__ void xcd_barrier_complete(unsigned* bar, unsigned x, unsigned& nloc, unsigned& nx) {
    const unsigned G = gridDim.x * gridDim.y * gridDim.z;
    unsigned sum, cnt, mine, sp = 0u;
    for (;;) {
        sum = 0u; cnt = 0u; mine = 0u;
#pragma unroll
        for (unsigned j = 0; j < 16; ++j) { const unsigned c = xb_ld(&bar[XB_XCNT(j)]); sum += c; cnt += (c > 0u) ? 1u : 0u; mine = (j == x) ? c : mine; }
        if (sum == G) break;
        __builtin_amdgcn_s_sleep(1);
        if ((++sp & 255u) == 0u) { if (xb_ld(&bar[XB_TMO])) break; if (sp > XB_SPIN_CAP) { atomicAdd(&bar[XB_TMO], 1u); break; } }
    }
    nloc = mine > 0u ? mine : 1u; nx = cnt > 0u ? cnt : 1u;
}
__device__ __forceinline__ void xcd_barrier(const XcdBarrier& b, int wave) {
    asm volatile("s_waitcnt vmcnt(0)" ::: "memory");
    __syncthreads();
    if (wg_leader(wave)) {
        unsigned* bar = b.bar;
        __builtin_amdgcn_s_waitcnt(0);
        unsigned nloc = b.st[0], nx = b.st[1];
        if (nloc == 0u) { xcd_barrier_complete(bar, b.x, nloc, nx); b.st[0] = nloc; b.st[1] = nx; }
        const unsigned old = xb_add(&bar[XB_XSUB(b.x)], 1u);
        const unsigned gen = old / nloc;
        if (old + 1u == (gen + 1u) * nloc) {
            __builtin_amdgcn_fence(__ATOMIC_RELEASE, "agent");
            asm volatile("s_waitcnt vmcnt(0)" ::: "memory");
            const unsigned og = xb_add(&bar[XB_TOP], 1u);
            const unsigned tg = og / nx;
            if (og + 1u == (tg + 1u) * nx) xb_add(&bar[XB_TOPGEN], 1u);
            else XB_SPIN(xb_ld(&bar[XB_TOPGEN]) == tg, bar);
            __builtin_amdgcn_fence(__ATOMIC_ACQUIRE, "agent");
            xb_add(&bar[XB_XGEN(b.x)], 1u);
            asm volatile("s_waitcnt vmcnt(0)" ::: "memory");
        } else {
            XB_SPIN(xb_ld(&bar[XB_XGEN(b.x)]) == gen, bar);
            __builtin_amdgcn_fence(__ATOMIC_ACQUIRE, "agent");
            asm volatile("s_waitcnt vmcnt(0)" ::: "memory");
        }
    }
    __syncthreads();
}

__device__ __forceinline__ void transpose_item(const float* W, const float* gain, int N, bf16_t* WT, int ldk, int koff, LAS float* scr, int item, int lane) {
    const int nblk = N / 32, kb = item / nblk, nb = item % nblk, k0 = 64 * kb, n0 = 32 * nb;
    const int c4 = lane & 7, kr = lane >> 3;
#pragma unroll
    for (int i = 0; i < 8; ++i) { const int kk = 8 * i + kr; const float g = gain ? gain[k0 + kk] : 1.f; const f32x4 v = *(const f32x4*)(W + (size_t)(k0 + kk) * N + n0 + 4 * c4);
        LAS float* d = scr + kk * 33 + 4 * c4; d[0] = v[0] * g; d[1] = v[1] * g; d[2] = v[2] * g; d[3] = v[3] * g; }
    asm volatile("s_waitcnt lgkmcnt(0)" ::: "memory");
    const int c = lane & 7;
#pragma unroll
    for (int j = 0; j < 4; ++j) { const int n = (lane >> 3) + 8 * j; const LAS float* s = scr + (8 * c) * 33 + n;
        u32x4 o; o.x = pk2(s[0 * 33], s[1 * 33]); o.y = pk2(s[2 * 33], s[3 * 33]); o.z = pk2(s[4 * 33], s[5 * 33]); o.w = pk2(s[6 * 33], s[7 * 33]);
        *(u32x4*)(WT + (size_t)(n0 + n) * ldk + koff + k0 + 8 * c) = o; }
    asm volatile("s_waitcnt lgkmcnt(0)" ::: "memory");
}
struct Job { const float* W; const float* g; int Kr, N; bf16_t* WT; int ldk, koff; };
__device__ __forceinline__ Job get_job(const Params& p, int j) {
    Job J; unsigned char* ws = p.ws;
    if (j < 6) { const int e = j / 3, t = j % 3;
        if (t == 0) { J.W = p.w_in_even + (size_t)e * 1024 * 1280; J.g = p.norm_mix + (2 * e) * 1024; J.Kr = 1024; J.N = 1280; J.WT = (bf16_t*)(ws + WS_WIN_E) + (size_t)e * 1280 * 1024; J.ldk = 1024; J.koff = 0; }
        else if (t == 1) { J.W = p.w_out_even + (size_t)e * 1024 * 1024; J.g = nullptr; J.Kr = 512; J.N = 1024; J.WT = (bf16_t*)(ws + WS_WOUT_E) + (size_t)e * 1024 * 1024; J.ldk = 1024; J.koff = 0; }
        else { J.W = p.w_out_even; J.g = nullptr; J.Kr = 0; J.N = 1024; J.WT = (bf16_t*)(ws + WS_WOUT_E) + (size_t)e * 1024 * 1024; J.ldk = 1024; J.koff = 512; }
    } else if (j < 10) { const int o = (j - 6) / 2, t = (j - 6) % 2;
        if (t == 0) { J.W = p.w_in_odd + (size_t)o * 1024 * 2048; J.g = p.norm_mix + (2 * o + 1) * 1024; J.Kr = 1024; J.N = 2048; J.WT = (bf16_t*)(ws + WS_WIN_O) + (size_t)o * 2048 * 1024; J.ldk = 1024; J.koff = 0; }
        else { J.W = p.w_out_odd + (size_t)o * 512 * 1024; J.g = nullptr; J.Kr = 512; J.N = 1024; J.WT = (bf16_t*)(ws + WS_WOUT_O) + (size_t)o * 1024 * 512; J.ldk = 512; J.koff = 0; }
    } else { const int l = (j - 10) / 2, t = (j - 10) % 2;
        if (t == 0) { J.W = p.w_up + (size_t)l * 1024 * 4096; J.g = p.norm_mlp + l * 1024; J.Kr = 1024; J.N = 4096; J.WT = (bf16_t*)(ws + WS_WUP) + (size_t)l * 4096 * 1024; J.ldk = 1024; J.koff = 0; }
        else { J.W = p.w_down + (size_t)l * 4096 * 1024; J.g = nullptr; J.Kr = 4096; J.N = 1024; J.WT = (bf16_t*)(ws + WS_WDN) + (size_t)l * 1024 * 4096; J.ldk = 4096; J.koff = 0; }
    }
    return J;
}
constexpr int NJOBS = 18;

__device__ __forceinline__ void sincos_d(float a, float& c, float& s) {
    const double x = (double)a; const double k = __builtin_rint(x * 0.63661977236758134308);
    const double r = x - k * 1.57079632679489661923; const double r2 = r * r;
    double sp = -1.0 / 1307674368000.0; sp = sp * r2 + 1.0 / 6227020800.0; sp = sp * r2 - 1.0 / 39916800.0; sp = sp * r2 + 1.0 / 362880.0; sp = sp * r2 - 1.0 / 5040.0; sp = sp * r2 + 1.0 / 120.0; sp = sp * r2 - 1.0 / 6.0; sp = sp * r2 + 1.0;
    const double sn = sp * r;
    double cp = 1.0 / 20922789888000.0; cp = cp * r2 - 1.0 / 87178291200.0; cp = cp * r2 + 1.0 / 479001600.0; cp = cp * r2 - 1.0 / 3628800.0; cp = cp * r2 + 1.0 / 40320.0; cp = cp * r2 - 1.0 / 720.0; cp = cp * r2 + 1.0 / 24.0; cp = cp * r2 - 0.5; cp = cp * r2 + 1.0;
    const int q = ((int)k) & 3;
    const double cc = (q == 0) ? cp : (q == 1) ? -sn : (q == 2) ? -cp : sn;
    const double ss = (q == 0) ? sn : (q == 1) ? cp : (q == 2) ? -sn : -cp;
    c = (float)cc; s = (float)ss;
}

struct KVFrag { bf16x8 kr[4]; bf16x8 vr[4]; };
__device__ __forceinline__ void load_frags(KVFrag& f, const bf16_t* K0, const bf16_t* V0, int kb, int mode, int rsel, int lane) {
    if (mode == 0) {
        const int eo = kb * 64 + lane * 8;
        const bf16_t* kp = K0 + eo; const bf16_t* vp = V0 + eo;
#pragma unroll
        for (int i = 0; i < 4; ++i) { f.kr[i] = *(const bf16x8*)(kp + 512 * i); f.vr[i] = *(const bf16x8*)(vp + 512 * i); }
    } else if (mode == 1) {
        const int k0 = lane >> 3;
        const int eo = ((((k0 & 3) * 4 + rsel) * 256) + (kb >> 2) + (k0 >> 2)) * 64 + (lane & 7) * 8;
        const bf16_t* kp = K0 + eo; const bf16_t* vp = V0 + eo;
#pragma unroll
        for (int i = 0; i < 4; ++i) { f.kr[i] = *(const bf16x8*)(kp + 128 * i); f.vr[i] = *(const bf16x8*)(vp + 128 * i); }
    } else {
        const int k0 = lane >> 3;
        const int eo = (k0 * 256 + (kb >> 4)) * 64 + (lane & 7) * 8;
        const bf16_t* kp = K0 + eo; const bf16_t* vp = V0 + eo;
#pragma unroll
        for (int i = 0; i < 4; ++i) { const int o = (i & 1) * (8 * 256 * 64) + (i >> 1) * 64; f.kr[i] = *(const bf16x8*)(kp + o); f.vr[i] = *(const bf16x8*)(vp + o); }
    }
}
typedef short s16x4 __attribute__((ext_vector_type(4)));
constexpr int KST_OFF = 6144, KST_RS = 144;
constexpr int VST_RS = 192;
struct HState { f32x16 o[2]; float m, l; };
__device__ __forceinline__ void stage_v(const KVFrag& f, LAS unsigned char* vst, int lane, int hi, bf16x8 (&vf)[2][2], bf16x8 (&kf)[4]) {
#pragma unroll
    for (int i = 0; i < 4; ++i) { const int c = lane + 64 * i; *(LAS bf16x8*)(vst + (c >> 3) * VST_RS + (c & 7) * 16) = f.vr[i]; *(LAS bf16x8*)(vst + KST_OFF + (c >> 3) * KST_RS + (c & 7) * 16) = f.kr[i]; }
    const LAS unsigned char* tb = vst + (8 * hi + ((lane & 15) >> 2)) * VST_RS + (16 * ((lane >> 4) & 1) + 4 * (lane & 3)) * 2;
#pragma unroll
    for (int ks = 0; ks < 2; ++ks)
#pragma unroll
        for (int dh = 0; dh < 2; ++dh) {
            const s16x4 lo = __builtin_bit_cast(s16x4, __builtin_amdgcn_ds_read_tr16_b64_v4i16((LAS s16x4*)(tb + (16 * ks) * VST_RS + dh * 64)));
            const s16x4 hi4 = __builtin_bit_cast(s16x4, __builtin_amdgcn_ds_read_tr16_b64_v4i16((LAS s16x4*)(tb + (16 * ks + 4) * VST_RS + dh * 64)));
            vf[ks][dh] = (bf16x8){lo[0], lo[1], lo[2], lo[3], hi4[0], hi4[1], hi4[2], hi4[3]};
        }
    const int l31 = lane & 31, jsw = (l31 & 0x13) | ((l31 & 4) << 1) | ((l31 & 8) >> 1);
    const LAS unsigned char* kb_ = vst + KST_OFF + jsw * KST_RS + 16 * hi;
#pragma unroll
    for (int d0 = 0; d0 < 4; ++d0) kf[d0] = *(const LAS bf16x8*)(kb_ + 32 * d0);
}
struct ORows { unsigned base_row, pstride, amask, ashift, ld, hcol; };
__device__ __forceinline__ unsigned orow_off(const ORows& R, int rr) { return (R.base_row + R.pstride * ((unsigned)rr & R.amask)) * R.ld + R.hcol + 64u * ((unsigned)rr >> R.ashift); }
constexpr int QST_RS = 144, QST_SET = 32 * QST_RS;
__device__ __forceinline__ void qk_tile(const bf16x8 (&kf)[4], const LAS unsigned char* qh, f32x16& s) {
    const f32x16 z = {0.f, 0.f, 0.f, 0.f, 0.f, 0.f, 0.f, 0.f, 0.f, 0.f, 0.f, 0.f, 0.f, 0.f, 0.f, 0.f};
    s = __builtin_amdgcn_mfma_f32_32x32x16_bf16(kf[0], *(const LAS bf16x8*)qh, z, 0, 0, 0);
#pragma unroll
    for (int d0 = 1; d0 < 4; ++d0) s = __builtin_amdgcn_mfma_f32_32x32x16_bf16(kf[d0], *(const LAS bf16x8*)(qh + 32 * d0), s, 0, 0, 0);
}
__device__ __forceinline__ void q_rows_load(const bf16_t* proj, const ORows& R, int lane, u32x4 (&qv)[4]) {
#pragma unroll
    for (int i = 0; i < 4; ++i) { const int c = lane + 64 * i; qv[i] = *(const u32x4*)(proj + (orow_off(R, c >> 3) + (unsigned)((c & 7) * 8))); }
}
__device__ __forceinline__ void q_rows_stage(const u32x4 (&qv)[4], LAS unsigned char* qset, int lane) {
#pragma unroll
    for (int i = 0; i < 4; ++i) { const int c = lane + 64 * i; *(LAS u32x4*)(qset + (c >> 3) * QST_RS + (c & 7) * 16) = qv[i]; }
}
__device__ __forceinline__ float max3f(float a, float b, float c) { return fmaxf(fmaxf(a, b), c); }
__device__ __forceinline__ float max2f(float a, float b) { return fmaxf(a, b); }
typedef float f32x2 __attribute__((ext_vector_type(2)));
typedef __bf16 bf16x2_t __attribute__((ext_vector_type(2)));
__device__ __forceinline__ unsigned cvtpk_s(float lo, float hi) { f32x2 v = {lo, hi}; bf16x2_t b = __builtin_convertvector(v, bf16x2_t); return __builtin_bit_cast(unsigned, b); }
__device__ __forceinline__ void softmax_head(f32x16& s, int kb, int lq, int radius, bool full, int hi, HState& S) {
    if (!full) {
#pragma unroll
        for (int r = 0; r < 16; ++r) { const int lk = kb + 16 * (r >> 3) + 8 * hi + (r & 7); const int d = lk - lq;
            const bool valid = (unsigned)(d + radius) <= (unsigned)(2 * radius); s[r] = valid ? s[r] : -INFINITY; }
    }
    float t0 = max3f(s[0], s[1], s[2]), t1 = max3f(s[3], s[4], s[5]);
    t0 = max3f(t0, s[6], s[7]); t1 = max3f(t1, s[8], s[9]); t0 = max3f(t0, s[10], s[11]); t1 = max3f(t1, s[12], s[13]);
    float tmax = max3f(t0, s[14], s[15]); tmax = max2f(tmax, t1);
    { auto rr = __builtin_amdgcn_permlane32_swap(__float_as_uint(tmax), __float_as_uint(tmax), false, false); tmax = max2f(__uint_as_float(rr[0]), __uint_as_float(rr[1])); }
    if (__builtin_amdgcn_ballot_w64(tmax > S.m + 8.0f) != 0ull) {
        const float mn = max2f(S.m, tmax), alpha = __builtin_amdgcn_exp2f(S.m - mn); S.m = mn; S.l *= alpha;
#pragma unroll
        for (int dh = 0; dh < 2; ++dh)
#pragma unroll
            for (int r = 0; r < 16; ++r) S.o[dh][r] *= alpha;
    }
}
__device__ __forceinline__ void softmax_tail(f32x16& s, HState& S, u32x4 (&pw)[2]) {
    const float mn = S.m;
#pragma unroll
    for (int r = 0; r < 16; ++r) s[r] -= mn;
#pragma unroll
    for (int r = 0; r < 16; ++r) s[r] = __builtin_amdgcn_exp2f(s[r]);
    float p0 = s[0], p1 = s[1];
#pragma unroll
    for (int r = 2; r < 16; r += 2) { p0 += s[r]; p1 += s[r + 1]; }
    S.l += p0 + p1;
#pragma unroll
    for (int ks = 0; ks < 2; ++ks) { pw[ks].x = cvtpk_s(s[8 * ks + 0], s[8 * ks + 1]); pw[ks].y = cvtpk_s(s[8 * ks + 2], s[8 * ks + 3]); pw[ks].z = cvtpk_s(s[8 * ks + 4], s[8 * ks + 5]); pw[ks].w = cvtpk_s(s[8 * ks + 6], s[8 * ks + 7]); }
}
__device__ __forceinline__ void softmax_tile(f32x16& s, int kb, int lq, int radius, bool full, int hi, HState& S, u32x4 (&pw)[2]) { softmax_head(s, kb, lq, radius, full, hi, S); softmax_tail(s, S, pw); }
#define MFMA_VALU_INTERLEAVE() do { _Pragma("unroll") for (int g_ = 0; g_ < 4; ++g_) { __builtin_amdgcn_sched_group_barrier(0x008, 1, 0); __builtin_amdgcn_sched_group_barrier(0x002, 14, 0); } } while (0)
#ifndef XTRA_MFMA
#define XTRA_MFMA 0
#endif
__device__ __forceinline__ void pv_tile(const bf16x8 (&vf)[2][2], const u32x4 (&pw)[2], HState& S) {
#pragma unroll
    for (int ks = 0; ks < 2; ++ks)
#pragma unroll
        for (int dh = 0; dh < 2; ++dh) S.o[dh] = __builtin_amdgcn_mfma_f32_32x32x16_bf16(vf[ks][dh], __builtin_bit_cast(bf16x8, pw[ks]), S.o[dh], 0, 0, 0);
    if (XTRA_MFMA) {
        u32x4 zz = {0u, 0u, 0u, 0u}; asm volatile("" : "+v"(zz));
#pragma unroll
        for (int k = 0; k < XTRA_MFMA; ++k) S.o[k & 1] = __builtin_amdgcn_mfma_f32_32x32x16_bf16(vf[0][k & 1], __builtin_bit_cast(bf16x8, zz), S.o[k & 1], 0, 0, 0);
    }
}
struct QSet { int lq, lqmin, lqmax; };
template <int NH>
__device__ __forceinline__ void tile_all(const KVFrag& f, const LAS unsigned char* ql, LAS unsigned char* vst, int lane, int hi, int kb, int radius, const QSet& qa, const QSet& qb, HState& A, HState& B) {
    bf16x8 vf[2][2], kf[4]; stage_v(f, vst, lane, hi, vf, kf);
    f32x16 sa; u32x4 pwa[2];
    qk_tile(kf, ql, sa);
    if (NH == 1) {
        softmax_tile(sa, kb, qa.lq, radius, (kb >= qa.lqmax - radius) && (kb + 31 <= qa.lqmin + radius), hi, A, pwa);
        pv_tile(vf, pwa, A);
    } else {
        f32x16 sb; u32x4 pwb[2];
        softmax_head(sa, kb, qa.lq, radius, (kb >= qa.lqmax - radius) && (kb + 31 <= qa.lqmin + radius), hi, A);
        __builtin_amdgcn_sched_barrier(0);
        qk_tile(kf, ql + QST_SET, sb);
        softmax_tail(sa, A, pwa);
        MFMA_VALU_INTERLEAVE();
        __builtin_amdgcn_sched_barrier(0);
        softmax_head(sb, kb, qb.lq, radius, (kb >= qb.lqmax - radius) && (kb + 31 <= qb.lqmin + radius), hi, B);
        __builtin_amdgcn_sched_barrier(0);
        pv_tile(vf, pwa, A);
        softmax_tail(sb, B, pwb);
        MFMA_VALU_INTERLEAVE();
        __builtin_amdgcn_sched_barrier(0);
        pv_tile(vf, pwb, B);
    }
}
template <int NH>
__device__ __forceinline__ void attn_pass(const LAS unsigned char* ql, LAS unsigned char* vst, int lane, const bf16_t* K0, const bf16_t* V0, int mode, int rsel, int L, int kb0, int nt, int radius,
                                          const QSet& qa, const QSet& qb, HState& A, HState& B) {
    const int lane31 = lane & 31, hi = lane >> 5;
    const int jsw = (lane31 & 0x13) | ((lane31 & 4) << 1) | ((lane31 & 8) >> 1);
    const int ilo = kb0 < 0 ? ((-kb0) >> 5) : 0, ihi = min(nt, (L - kb0) >> 5);
    if (ilo >= ihi) return;
    KVFrag fa, fb;
    load_frags(fa, K0, V0, kb0 + 32 * ilo, mode, rsel, lane);
    int i = ilo;
    for (; i + 1 < ihi; i += 2) {
        const int kb = kb0 + 32 * i;
        __builtin_amdgcn_sched_barrier(0);
        load_frags(fb, K0, V0, kb + 32, mode, rsel, lane);
        tile_all<NH>(fa, ql, vst, lane, hi, kb, radius, qa, qb, A, B);
        __builtin_amdgcn_sched_barrier(0);
        load_frags(fa, K0, V0, kb0 + 32 * min(i + 2, ihi - 1), mode, rsel, lane);
        tile_all<NH>(fb, ql, vst, lane, hi, kb + 32, radius, qa, qb, A, B);
    }
    __builtin_amdgcn_sched_barrier(0);
    if (i < ihi) tile_all<NH>(fa, ql, vst, lane, hi, kb0 + 32 * i, radius, qa, qb, A, B);
}
constexpr int OST_RS = 144;
__device__ __forceinline__ void orows_put(const f32x16 (&o)[2], float sc, LAS unsigned char* stg, int lane) {
    const int q = lane & 31, hi = lane >> 5;
#pragma unroll
    for (int dh = 0; dh < 2; ++dh)
#pragma unroll
        for (int g = 0; g < 4; ++g) { u32x2 w; w.x = pk2(o[dh][4 * g] * sc, o[dh][4 * g + 1] * sc); w.y = pk2(o[dh][4 * g + 2] * sc, o[dh][4 * g + 3] * sc);
            *(LAS u32x2*)(stg + q * OST_RS + (32 * dh + 8 * g + 4 * hi) * 2) = w; }
}
__device__ __forceinline__ void orows_store(LAS unsigned char* stg, bf16_t* mix, const ORows& R, int lane) {
#pragma unroll
    for (int i = 0; i < 4; ++i) { const int c = lane + 64 * i, rr = c >> 3, pc = c & 7;
        const u32x4 v = *(const LAS u32x4*)(stg + rr * OST_RS + pc * 16);
        *(u32x4*)(mix + (orow_off(R, rr) + (unsigned)(pc * 8))) = v; }
}
__device__ __forceinline__ void attn_store(const HState& S, bf16_t* mix, const ORows& R, LAS unsigned char* stg, int lane) {
    float l = pg8::sum_x32(S.l);
    orows_put(S.o, 1.0f / l, stg, lane);
    orows_store(stg, mix, R, lane);
}
__device__ __forceinline__ void attn_store_lse(const HState& S, bf16_t* mix, const ORows& R, LAS unsigned char* stg, float* lsep, int lane) {
    float l = pg8::sum_x32(S.l);
    orows_put(S.o, 1.0f / l, stg, lane);
    orows_store(stg, mix, R, lane);
    if ((lane >> 5) == 0) *lsep = S.m + __builtin_amdgcn_logf(l);
}
__device__ __forceinline__ void attn_store_merge(const HState& S, bf16_t* mix, const ORows& R, LAS unsigned char* stg, const float* lsep, int lane) {
    const int q = lane & 31, hi = lane >> 5;
    u32x4 xr[4];
#pragma unroll
    for (int i = 0; i < 4; ++i) { const int c = lane + 64 * i; xr[i] = *(const u32x4*)(mix + (orow_off(R, c >> 3) + (unsigned)((c & 7) * 8))); }
    float l = pg8::sum_x32(S.l);
    const float lx = *lsep, M = fmaxf(S.m, lx), wy = __builtin_amdgcn_exp2f(S.m - M), wx = __builtin_amdgcn_exp2f(lx - M);
    const float inv = 1.0f / (wy * l + wx), ay = wy * inv, ax = wx * inv;
#pragma unroll
    for (int i = 0; i < 4; ++i) { const int c = lane + 64 * i; *(LAS u32x4*)(stg + (c >> 3) * OST_RS + (c & 7) * 16) = xr[i]; }
#pragma unroll
    for (int dh = 0; dh < 2; ++dh)
#pragma unroll
        for (int g = 0; g < 4; ++g) { LAS u32x2* slot = (LAS u32x2*)(stg + q * OST_RS + (32 * dh + 8 * g + 4 * hi) * 2); const u32x2 old = *slot;
            u32x2 w; w.x = pk2(S.o[dh][4 * g] * ay + __uint_as_float(old.x << 16) * ax, S.o[dh][4 * g + 1] * ay + __uint_as_float(old.x & 0xffff0000u) * ax);
            w.y = pk2(S.o[dh][4 * g + 2] * ay + __uint_as_float(old.y << 16) * ax, S.o[dh][4 * g + 3] * ay + __uint_as_float(old.y & 0xffff0000u) * ax);
            *slot = w; }
    orows_store(stg, mix, R, lane);
}
__device__ __forceinline__ void hstate_init(HState& S, float m, float l) {
#pragma unroll
    for (int r = 0; r < 16; ++r) { S.o[0][r] = 0.f; S.o[1][r] = 0.f; }
    S.m = m; S.l = l;
}

__device__ __forceinline__ void attn_even_unit(int uid, const bf16_t* proj, const bf16_t* kd, const bf16_t* vd, bf16_t* mix, const float* sink, int lane, LAS bf16x8* qlds  , LAS unsigned char* vst) {
    asm volatile("v_mbcnt_lo_u32_b32 %0, -1, 0\n\tv_mbcnt_hi_u32_b32 %0, -1, %0" : "=v"(lane));
    const int qt = uid & 127, kvh = (uid >> 7) & 1, b = uid >> 8;
    const int q0 = qt * 32;
    const bf16_t* K0 = kd + (size_t)(b * 2 + kvh) * (4096 * 64);
    const bf16_t* V0 = vd + (size_t)(b * 2 + kvh) * (4096 * 64);
    for (int hp = 0; hp < 2; ++hp) {
        const int h0 = kvh * 4 + hp * 2;
        asm volatile("v_mbcnt_lo_u32_b32 %0, -1, 0\n\tv_mbcnt_hi_u32_b32 %0, -1, %0" : "=v"(lane));
        const int lane31 = lane & 31, hi = lane >> 5, t = q0 + lane31; const QSet qs{t, q0, q0 + 31};
        { u32x4 qa_[4], qb_[4];
          const ORows Ra{(unsigned)(b * SEQ + q0), 1u, 31u, 5u, 1280u, (unsigned)(h0 * 64)}, Rb{(unsigned)(b * SEQ + q0), 1u, 31u, 5u, 1280u, (unsigned)((h0 + 1) * 64)};
          q_rows_load(proj, Ra, lane, qa_); q_rows_load(proj, Rb, lane, qb_);
          q_rows_stage(qa_, (LAS unsigned char*)qlds, lane); q_rows_stage(qb_, (LAS unsigned char*)qlds + QST_SET, lane); }
        HState A, B;
        hstate_init(A, sink[h0] * 1.4426950408889634f, (hi == 0) ? 1.f : 0.f); hstate_init(B, sink[h0 + 1] * 1.4426950408889634f, (hi == 0) ? 1.f : 0.f);
        attn_pass<2>((const LAS unsigned char*)qlds + lane31 * QST_RS + 16 * hi, vst, lane, K0, V0, 0, 0, SEQ, q0 - 128, 9, 128, qs, qs, A, B);
        asm volatile("v_mbcnt_lo_u32_b32 %0, -1, 0\n\tv_mbcnt_hi_u32_b32 %0, -1, %0" : "=v"(lane));
        { const ORows R{(unsigned)(b * SEQ + q0), 1u, 31u, 5u, 1024u, (unsigned)(h0 * 64)}; attn_store(A, mix, R, vst, lane); }
        { const ORows R{(unsigned)(b * SEQ + q0), 1u, 31u, 5u, 1024u, (unsigned)((h0 + 1) * 64)}; attn_store(B, mix, R, vst, lane); }
    }
}
__device__ __forceinline__ void attn_x_unit(int uid, const bf16_t* proj, const bf16_t* kd, const bf16_t* vd, bf16_t* mix, float* lse, int lane, LAS bf16x8* qlds, LAS unsigned char* vst) {
    asm volatile("v_mbcnt_lo_u32_b32 %0, -1, 0\n\tv_mbcnt_hi_u32_b32 %0, -1, %0" : "=v"(lane));
    const int qt = uid & 127, kvh = (uid >> 7) & 3, b = uid >> 9, lane31 = lane & 31, hi = lane >> 5;
    const int q0 = qt * 32, t = q0 + lane31; const size_t row = (size_t)b * SEQ + t;
    const bf16_t* K0 = kd + (size_t)(b * 4 + kvh) * (4096 * 64);
    const bf16_t* V0 = vd + (size_t)(b * 4 + kvh) * (4096 * 64);
    const QSet qs{t, q0, q0 + 31};
    { u32x4 qa_[4], qb_[4];
      const ORows Ra{(unsigned)(b * SEQ + q0), 1u, 31u, 5u, 2048u, (unsigned)((kvh * 2) * 64)}, Rb{(unsigned)(b * SEQ + q0), 1u, 31u, 5u, 2048u, (unsigned)((kvh * 2 + 1) * 64)};
      q_rows_load(proj, Ra, lane, qa_); q_rows_load(proj, Rb, lane, qb_);
      q_rows_stage(qa_, (LAS unsigned char*)qlds, lane); q_rows_stage(qb_, (LAS unsigned char*)qlds + QST_SET, lane); }
    HState A, B; hstate_init(A, -1e30f, 0.f); hstate_init(B, -1e30f, 0.f);
    attn_pass<2>((const LAS unsigned char*)qlds + lane31 * QST_RS + 16 * hi, vst, lane, K0, V0, 2, 0, SEQ, q0 - 64, 5, 64, qs, qs, A, B);
    { const ORows R{(unsigned)(b * SEQ + q0), 1u, 31u, 5u, 512u, (unsigned)((kvh * 2) * 64)}; attn_store_lse(A, mix, R, vst, lse + (size_t)(kvh * 2) * NTOK + row, lane); }
    { const ORows R{(unsigned)(b * SEQ + q0), 1u, 31u, 5u, 512u, (unsigned)((kvh * 2 + 1) * 64)}; attn_store_lse(B, mix, R, vst, lse + (size_t)(kvh * 2 + 1) * NTOK + row, lane); }
}
__device__ __forceinline__ void attn_odd_unit(int uid, const bf16_t* proj, const bf16_t* kd, const bf16_t* vd, bf16_t* mix, const float* lse, int lane, LAS bf16x8* qlds, LAS unsigned char* vst) {
    asm volatile("v_mbcnt_lo_u32_b32 %0, -1, 0\n\tv_mbcnt_hi_u32_b32 %0, -1, %0" : "=v"(lane));
    const int rp = uid & 7, lt = (uid >> 3) & 15, kvh = (uid >> 7) & 3, b = uid >> 9, lane31 = lane & 31, hi = lane >> 5;
    const int rA = (rp & 3) + 8 * (rp >> 2), rB = rA + 4;
    const int j = lane31 >> 4, a = lane31 & 15, l0 = lt * 16, tA = rA + 16 * (l0 + a); const size_t rowA = (size_t)b * SEQ + tA, rowB = rowA + 4;
    HState A, B; hstate_init(A, -1e30f, 0.f); hstate_init(B, -1e30f, 0.f);
    const size_t LAY = (size_t)16 * 256 * 4096;
    const size_t bk = (size_t)(b * 4 + kvh) * (4096 * 64);
#pragma unroll
    for (int g = 1; g < 3; ++g) {
        const int D = (g == 0) ? 1 : (g == 1 ? 4 : 16), s = 16 / D, L = SEQ / D, nt = (g == 0) ? 12 : (g == 1 ? 6 : 5);
        const int head = g * 8 + kvh * 2 + j;
        { u32x4 qa_[4], qb_[4];
          const ORows Ra{(unsigned)(b * SEQ + rA + 16 * l0), 16u, 15u, 4u, 2048u, (unsigned)((g * 8 + kvh * 2) * 64)}, Rb{(unsigned)(b * SEQ + rB + 16 * l0), 16u, 15u, 4u, 2048u, (unsigned)((g * 8 + kvh * 2) * 64)};
          q_rows_load(proj, Ra, lane, qa_); q_rows_load(proj, Rb, lane, qb_);
          q_rows_stage(qa_, (LAS unsigned char*)qlds, lane); q_rows_stage(qb_, (LAS unsigned char*)qlds + QST_SET, lane); }
        const int cA = rA / D, cB = rB / D;
        const QSet qa{cA + s * (l0 + a), cA + s * l0, cA + s * (l0 + 15)}, qb{cB + s * (l0 + a), cB + s * l0, cB + s * (l0 + 15)};
        const int kb0 = (s * l0 - 64) & ~31;
        if (g < 2) {
            attn_pass<2>((const LAS unsigned char*)qlds + lane31 * QST_RS + 16 * hi, vst, lane, kd + bk, vd + bk, 1, rA & 3, L, kb0, nt, 64, qa, qb, A, B);
        } else {
            attn_pass<1>((const LAS unsigned char*)qlds + lane31 * QST_RS + 16 * hi, vst, lane, kd + bk + (size_t)(rA * L) * 64, vd + bk + (size_t)(rA * L) * 64, 0, 0, L, kb0, nt, 64, qa, qa, A, A);
            attn_pass<1>((const LAS unsigned char*)qlds + lane31 * QST_RS + 16 * hi + QST_SET, vst, lane, kd + bk + (size_t)(rB * L) * 64, vd + bk + (size_t)(rB * L) * 64, 0, 0, L, kb0, nt, 64, qb, qb, B, B);
        }
    }
    { const ORows R{(unsigned)(b * SEQ + rA + 16 * l0), 16u, 15u, 4u, 512u, (unsigned)((kvh * 2) * 64)}; attn_store_merge(A, mix, R, vst, lse + (size_t)(kvh * 2 + j) * NTOK + rowA, lane); }
    { const ORows R{(unsigned)(b * SEQ + rB + 16 * l0), 16u, 15u, 4u, 512u, (unsigned)((kvh * 2) * 64)}; attn_store_merge(B, mix, R, vst, lse + (size_t)(kvh * 2 + j) * NTOK + rowB, lane); }
}
__device__ __forceinline__ void bf8_unpack(const u32x4 v, float (&f)[8]) {
#pragma unroll
    for (int i = 0; i < 4; ++i) { f[2 * i] = __uint_as_float(v[i] << 16); f[2 * i + 1] = __uint_as_float(v[i] & 0xffff0000u); }
}
__device__ __forceinline__ void pool_rows32(int row0, const bf16_t* proj, bf16_t* mix, int lane) {
    const int t0 = row0 & 4095, w2 = 1 << (lane >> 4);
    const bf16_t* base = proj + (size_t)(row0 - t0) * 1280 + 768 + 8 * lane;
    float S[8];
#pragma unroll
    for (int i = 0; i < 8; ++i) S[i] = 0.f;
    {
        u32x4 v[16];
#pragma unroll
        for (int k = 0; k < 16; ++k) { const int off = k - 8, tt = t0 + off; const bool ok = (off >= -w2) && (off < w2) && (tt >= 0) && (tt < SEQ);
            v[k] = (u32x4){0u, 0u, 0u, 0u}; if (ok) v[k] = *(const u32x4*)(base + (unsigned)tt * 1280u); }
#pragma unroll
        for (int k = 0; k < 16; ++k) { float f[8]; bf8_unpack(v[k], f);
#pragma unroll
            for (int i = 0; i < 8; ++i) S[i] += f[i]; }
    }
#pragma unroll 1
    for (int rb = 0; rb < 32; rb += 8) {
        u32x4 ve[8], vl[8], vc[8];
#pragma unroll
        for (int r = 0; r < 8; ++r) { const int t = t0 + rb + r, te = t + w2, tl = t - w2;
            vc[r] = *(const u32x4*)(base + (unsigned)t * 1280u);
            ve[r] = (u32x4){0u, 0u, 0u, 0u}; if (te < SEQ) ve[r] = *(const u32x4*)(base + (unsigned)te * 1280u);
            vl[r] = (u32x4){0u, 0u, 0u, 0u}; if (tl >= 0) vl[r] = *(const u32x4*)(base + (unsigned)tl * 1280u); }
#pragma unroll
        for (int r = 0; r < 8; ++r) { const int t = t0 + rb + r, lo = max(t - w2, 0), hi = min(t + w2, SEQ);
            const float inv = 1.0f / (float)(hi - lo);
            float c[8], d[8]; bf8_unpack(vc[r], c);
#pragma unroll
            for (int i = 0; i < 8; ++i) d[i] = S[i] * inv - c[i];
            u32x4 w; w.x = pk2(d[0], d[1]); w.y = pk2(d[2], d[3]); w.z = pk2(d[4], d[5]); w.w = pk2(d[6], d[7]);
            *(u32x4*)(mix + (size_t)(row0 + rb + r) * 1024 + 512 + 8 * lane) = w;
            float e[8], l[8]; bf8_unpack(ve[r], e); bf8_unpack(vl[r], l);
#pragma unroll
            for (int i = 0; i < 8; ++i) S[i] += e[i] - l[i]; }
    }
}

__global__ void __launch_bounds__(NTHREADS, 2) fwd_megakernel(Params p) {
    extern __shared__ __attribute__((aligned(16))) unsigned char lds_raw[];
    cg::grid_group grid = cg::this_grid();
    LAS unsigned char* lds = (LAS unsigned char*)lds_raw;
    const int tid = threadIdx.x, lane = tid & 63, wave = __builtin_amdgcn_readfirstlane(tid >> 6);
    const int G = gridDim.x, bx = blockIdx.x;
    const int gw = bx * NWAVES + wave, NGW = G * NWAVES;
    const int vb = (G % 8 == 0) ? (bx % 8) * (G / 8) + bx / 8 : bx;
    unsigned char* ws = p.ws;
    bf16_t* XB = (bf16_t*)(ws + WS_XB); bf16_t* PROJ = (bf16_t*)(ws + WS_PROJ); bf16_t* VT = (bf16_t*)(ws + WS_VT); bf16_t* MIX = (bf16_t*)(ws + WS_MIX); bf16_t* KD = (bf16_t*)(ws + WS_KD); bf16_t* UB = (bf16_t*)(ws + WS_U);
    float* PART = (float*)(ws + WS_PART); float* LSE = (float*)(ws + WS_LSE); float* CS = (float*)(ws + WS_CS); float* WF = (float*)(ws + WS_WF);

    volatile LAS unsigned* MISC = (volatile LAS unsigned*)(lds + MISC_OFF);
    if (tid < 4) MISC[tid] = 0u;
    unsigned* BAR = (unsigned*)(ws + WS_BAR);
    if (bx == 0) for (int i = tid; i < XCD_BAR_WORDS; i += NTHREADS) BAR[i] = 0u;
    __syncthreads();
#ifndef REP_PRO
#define REP_PRO 1
#endif
    for (int rep_p = 0; rep_p < REP_PRO; ++rep_p)
    {
        const int gt = bx * NTHREADS + tid, NT = G * NTHREADS;
        for (int u = gw; u < 2048; u += NGW) {
            const int nb = u & 15, k8 = (u >> 4) & 15, g = (u >> 8) & 3, e = u >> 10, n = nb * 64 + lane, k0 = k8 * 8;
            const float* wp = p.w_pool + ((size_t)(e * 4 + g) * 128 + k0) * 128; const float* sc = p.pool_scale + e * 512 + g * 128;
            const float* wo = p.w_out_even + ((size_t)e * 1024 + 512 + g * 128) * 1024 + n;
            float acc[8];
#pragma unroll
            for (int i = 0; i < 8; ++i) acc[i] = 0.f;
#pragma unroll 16
            for (int jj = 0; jj < 128; ++jj) { const float w = wo[(size_t)jj * 1024] * sc[jj];
#pragma unroll
                for (int i = 0; i < 8; ++i) acc[i] += wp[i * 128 + jj] * w; }
            u32x4 o; o.x = pk2(acc[0], acc[1]); o.y = pk2(acc[2], acc[3]); o.z = pk2(acc[4], acc[5]); o.w = pk2(acc[6], acc[7]);
            *(u32x4*)((bf16_t*)(ws + WS_WOUT_E) + (size_t)e * 1024 * 1024 + (size_t)n * 1024 + 512 + g * 128 + k0) = o;
        }
        for (int idx = gt; idx < SEQ * 8; idx += NT) {
            const int i = idx & 7, pos = idx >> 3;
            const float inv = (i == 0) ? 1.0f : (i == 1) ? 0.1939227432012558f : (i == 2) ? 0.03760603070259094f : (i == 3) ? 0.007292664609849453f : (i == 4) ? 0.0014142135623842478f : (i == 5) ? 0.00027424818836152554f : (i == 6) ? 5.3182957344688475e-05f : 1.0313385246263351e-05f;
            float c, s; sincos_d((float)pos * inv, c, s);
            CS[pos * 16 + i] = c; CS[pos * 16 + 8 + i] = s;
        }
        {
            LAS float* scr = (LAS float*)(lds + wave * 16384);
            int itbase = 0;
            for (int jb = 0; jb < NJOBS; ++jb) {
                const Job J = get_job(p, jb); const int nitems = (J.Kr / 64) * (J.N / 32);
                const int first = (gw - (itbase % NGW) + NGW) % NGW;
                for (int it = first; it < nitems; it += NGW) transpose_item(J.W, J.g, J.N, J.WT, J.ldk, J.koff, scr, it, lane);
                itbase += nitems;
            }
        }
        for (int r0 = gw * 4; r0 < NTOK; r0 += NGW * 4) {
            f32x4 v[4][4];
#pragma unroll
            for (int q = 0; q < 4; ++q) { const f32x4* xr = (const f32x4*)(p.x + (size_t)(r0 + q) * DM) + lane;
#pragma unroll
                for (int jj = 0; jj < 4; ++jj) v[q][jj] = xr[64 * jj]; }
            float ssq[4];
#pragma unroll
            for (int q = 0; q < 4; ++q) { float ss = 0.f; unsigned long long* o8 = (unsigned long long*)(XB + (size_t)(r0 + q) * DM) + lane;
#pragma unroll
                for (int jj = 0; jj < 4; ++jj) { ss += (v[q][jj][0] * v[q][jj][0] + v[q][jj][1] * v[q][jj][1]) + (v[q][jj][2] * v[q][jj][2] + v[q][jj][3] * v[q][jj][3]);
                    o8[64 * jj] = (unsigned long long)pk2(v[q][jj][0], v[q][jj][1]) | ((unsigned long long)pk2(v[q][jj][2], v[q][jj][3]) << 32); }
                ssq[q] = wave_sum(ss); }
            { const int sl = lane >= 60 ? 0 : 1 + (lane >> 2), qq = lane >= 60 ? lane - 60 : (lane & 3);
              const float val = lane >= 60 ? (qq == 0 ? ssq[0] : qq == 1 ? ssq[1] : qq == 2 ? ssq[2] : ssq[3]) : 0.f;
              PART[(size_t)sl * NTOK + r0 + qq] = val; }
        }
    }
    grid.sync();
    const XcdBarrier xbar = xcd_barrier_post(BAR, MISC, wave);
#define GRID_BAR() xcd_barrier(xbar, wave)
#ifndef XBAR_EXTRA
#define XBAR_EXTRA 0
#endif
    for (int xs = 0; xs < XBAR_EXTRA; ++xs) GRID_BAR();

    for (int layer = 0; layer < 4; ++layer) {
        const int odd = layer & 1, li = layer >> 1;
        {
            const int N = odd ? 2048 : 1280;
            const bf16_t* Wt = odd ? (const bf16_t*)(ws + WS_WIN_O) + (size_t)li * 2048 * 1024 : (const bf16_t*)(ws + WS_WIN_E) + (size_t)li * 1280 * 1024;
            pg8::Gemm g{XB, Wt, NTOK, N, 1024}; pg8::StaticOrder S; S.init(NTOK, N, G, bx);
            pg8::EpiProj E{PROJ, N, PART, CS, VT, KD, odd};
#ifndef REP_IN
#define REP_IN 1
#endif
            for (int rep = 0; rep < REP_IN; ++rep)
            pg8::gemm_phase<pg8::EpiProj, pg8::StaticOrder, true, true>(lds, g, S, E, wave);
        }
        GRID_BAR();
#ifndef REP_ATTN_E
#define REP_ATTN_E 1
#endif
#ifndef REP_ATTN_O
#define REP_ATTN_O 1
#endif
        for (int rep = 0; rep < (odd ? REP_ATTN_O : REP_ATTN_E); ++rep) {
        int lane_o; asm volatile("v_mbcnt_lo_u32_b32 %0, -1, 0\n\tv_mbcnt_hi_u32_b32 %0, -1, %0" : "=v"(lane_o)); const int gwv = vb * NWAVES + wave;
        if (odd) {
#ifndef REP_X
#define REP_X 1
#endif
            for (int rq = 0; rq < REP_X; ++rq)
            for (int uid = gwv; uid < 8192; uid += NGW) attn_x_unit(uid, PROJ, KD, VT, MIX, LSE, lane_o, (LAS bf16x8*)(lds + wave * WAVE_LDS), lds + wave * WAVE_LDS + 2 * QST_SET);
            GRID_BAR();
            int lane_y; asm volatile("v_mbcnt_lo_u32_b32 %0, -1, 0\n\tv_mbcnt_hi_u32_b32 %0, -1, %0" : "=v"(lane_y));
            for (int uid = gwv; uid < 8192; uid += NGW) attn_odd_unit(uid, PROJ, KD, VT, MIX, LSE, lane_y, (LAS bf16x8*)(lds + wave * WAVE_LDS), lds + wave * WAVE_LDS + 2 * QST_SET);
        } else {
#ifndef REP_EATT
#define REP_EATT 1
#endif
#ifndef REP_POOL
#define REP_POOL 1
#endif
            for (int rq = 0; rq < REP_EATT; ++rq)
            for (int uid = gwv; uid < 4096; uid += NGW) attn_even_unit(uid, PROJ, KD, VT, MIX, p.sink + li * 8, lane_o, (LAS bf16x8*)(lds + wave * WAVE_LDS), lds + wave * WAVE_LDS + 2 * QST_SET);
            int lane_p; asm volatile("v_mbcnt_lo_u32_b32 %0, -1, 0\n\tv_mbcnt_hi_u32_b32 %0, -1, %0" : "=v"(lane_p));
            for (int rq = 0; rq < REP_POOL; ++rq)
            for (int r0 = gwv * 32; r0 < NTOK; r0 += NGW * 32) pool_rows32(r0, PROJ, MIX, lane_p);
        }
        }
        GRID_BAR();
        {
            const int K = odd ? 512 : 1024;
            const bf16_t* Wt = odd ? (const bf16_t*)(ws + WS_WOUT_O) + (size_t)li * 1024 * 512 : (const bf16_t*)(ws + WS_WOUT_E) + (size_t)li * 1024 * 1024;
            pg8::Gemm g{MIX, Wt, NTOK, 1024, K}; pg8::StaticOrder S; S.init(NTOK, 1024, G, bx);
#ifndef REP_OUT
#define REP_OUT 0
#endif
            for (int rq = 0; rq < REP_OUT; ++rq) {
                pg8::EpiRes E2{XB, PART, (bf16_t*)(ws + 800 * MiB), (float*)(ws + 930 * MiB)};
                pg8::gemm_phase<pg8::EpiRes, pg8::StaticOrder, true, true>(lds, g, S, E2, wave);
            }
            pg8::EpiRes E{XB, PART, XB, PART};
            pg8::gemm_phase<pg8::EpiRes, pg8::StaticOrder, true, true>(lds, g, S, E, wave);
        }
        GRID_BAR();
        {
            pg8::Gemm g{XB, (const bf16_t*)(ws + WS_WUP) + (size_t)layer * 4096 * 1024, NTOK, 4096, 1024}; pg8::StaticOrder S; S.init(NTOK, 4096, G, bx);
            pg8::EpiUp E{UB, PART};
#ifndef REP_UP
#define REP_UP 1
#endif
            for (int rep = 0; rep < REP_UP; ++rep)
            pg8::gemm_phase<pg8::EpiUp, pg8::StaticOrder, true, true>(lds, g, S, E, wave);
        }
        GRID_BAR();
        {
            pg8::Gemm g{UB, (const bf16_t*)(ws + WS_WDN) + (size_t)layer * 1024 * 4096, NTOK, 1024, 4096}; pg8::StaticOrder S; S.init(NTOK, 1024, G, bx, 1);
#ifndef REP_DOWN
#define REP_DOWN 0
#endif
            for (int rq = 0; rq < REP_DOWN; ++rq) {
                pg8::EpiRes E2{XB, PART, (bf16_t*)(ws + 800 * MiB), (float*)(ws + 930 * MiB)};
                pg8::gemm_phase<pg8::EpiRes, pg8::StaticOrder, true, true>(lds, g, S, E2, wave);
            }
            pg8::EpiRes E{XB, PART, XB, PART};
            pg8::gemm_phase<pg8::EpiRes, pg8::StaticOrder, true, true>(lds, g, S, E, wave);
        }
        GRID_BAR();
    }
#ifndef REP_FINAL
#define REP_FINAL 1
#endif
    for (int rep_f = 0; rep_f < REP_FINAL; ++rep_f) {
    int lane_f; asm volatile("v_mbcnt_lo_u32_b32 %0, -1, 0\n\tv_mbcnt_hi_u32_b32 %0, -1, %0" : "=v"(lane_f)); const int gw_f = gw;
    for (int r0 = gw_f * 4; r0 < NTOK; r0 += NGW * 4) {
        unsigned long long xw[4][4];
        float ps = PART[(size_t)(lane_f & 15) * NTOK + r0 + (lane_f >> 4)];
#pragma unroll
        for (int q = 0; q < 4; ++q) { const unsigned long long* xr = (const unsigned long long*)(XB + (size_t)(r0 + q) * DM) + lane_f;
#pragma unroll
            for (int jj = 0; jj < 4; ++jj) xw[q][jj] = xr[64 * jj]; }
        ps += __builtin_bit_cast(float, __builtin_amdgcn_mov_dpp(__builtin_bit_cast(int, ps), 0xB1, 0xF, 0xF, true));
        ps += __builtin_bit_cast(float, __builtin_amdgcn_mov_dpp(__builtin_bit_cast(int, ps), 0x4E, 0xF, 0xF, true));
        ps += __builtin_bit_cast(float, __builtin_amdgcn_mov_dpp(__builtin_bit_cast(int, ps), 0x124, 0xF, 0xF, true));
        ps += __builtin_bit_cast(float, __builtin_amdgcn_mov_dpp(__builtin_bit_cast(int, ps), 0x128, 0xF, 0xF, true));
        const f32x4* gr = (const f32x4*)p.norm_final + lane_f;
#pragma unroll
        for (int q = 0; q < 4; ++q) {
            const float s = __builtin_bit_cast(float, __builtin_amdgcn_readlane(__builtin_bit_cast(int, ps), 16 * q));
            const float rs = __builtin_amdgcn_rsqf(s * (1.0f / 1024.0f) + 1e-6f);
            f32x4* orow = (f32x4*)(p.out + (size_t)(r0 + q) * DM) + lane_f;
#pragma unroll
            for (int jj = 0; jj < 4; ++jj) { const unsigned long long w = xw[q][jj]; const unsigned lo = (unsigned)w, hi = (unsigned)(w >> 32); const f32x4 gg = gr[64 * jj];
                f32x4 v; v[0] = __uint_as_float(lo << 16); v[1] = __uint_as_float(lo & 0xffff0000u); v[2] = __uint_as_float(hi << 16); v[3] = __uint_as_float(hi & 0xffff0000u);
                __builtin_nontemporal_store(v * rs * gg, &orow[64 * jj]); }
        }
    }
    }
}

extern "C" void kernel_launch(void* const* d_in, const int* in_sizes, int n_in, void* d_out, int out_size, void* d_ws, size_t ws_size, hipStream_t stream) {
    static int grid_blocks = 0;
    if (grid_blocks == 0) {
        if (n_in != 13 || out_size != NTOK * DM || ws_size < WS_END) { fprintf(stderr, "kernel_launch: unexpected shapes (n_in %d out %d ws %zu)\n", n_in, out_size, ws_size); grid_blocks = -1; return; }
        int dev = 0, cus = 0, per_cu = 0;
        hipGetDevice(&dev); hipDeviceGetAttribute(&cus, hipDeviceAttributeMultiprocessorCount, dev);
        hipFuncSetAttribute((const void*)fwd_megakernel, hipFuncAttributeMaxDynamicSharedMemorySize, LDS_ALLOC);
        hipOccupancyMaxActiveBlocksPerMultiprocessor(&per_cu, (const void*)fwd_megakernel, NTHREADS, LDS_ALLOC);
        if (per_cu < 1) per_cu = 1;
        (void)hipGetLastError();
        grid_blocks = cus * per_cu;
    }
    if (grid_blocks < 0) return;
    Params p{};
    p.x = (const float*)d_in[0]; p.norm_mix = (const float*)d_in[1]; p.norm_mlp = (const float*)d_in[2]; p.norm_final = (const float*)d_in[3];
    p.w_in_even = (const float*)d_in[4]; p.w_out_even = (const float*)d_in[5]; p.sink = (const float*)d_in[6]; p.w_pool = (const float*)d_in[7]; p.pool_scale = (const float*)d_in[8];
    p.w_in_odd = (const float*)d_in[9]; p.w_out_odd = (const float*)d_in[10]; p.w_up = (const float*)d_in[11]; p.w_down = (const float*)d_in[12];
    p.out = (float*)d_out; p.ws = (unsigned char*)d_ws;
    void* args[] = {&p};
    hipError_t e = hipLaunchCooperativeKernel((const void*)fwd_megakernel, dim3(grid_blocks), dim3(NTHREADS), args, LDS_ALLOC, stream);
    if (e != hipSuccess) fprintf(stderr, "cooperative launch failed: %s (grid %d)\n", hipGetErrorString(e), grid_blocks);
}
```

```cpp
#include <hip/hip_runtime.h>
#include <hip/hip_cooperative_groups.h>
#include <cstdio>
#include <cstdint>
namespace cg = cooperative_groups;
namespace pg8 {
#define PG8_LAS __attribute__((address_space(3)))
typedef unsigned short bf16_t;
typedef short bf16x8 __attribute__((ext_vector_type(8)));
typedef float f32x4 __attribute__((ext_vector_type(4)));
typedef unsigned u32x4 __attribute__((ext_vector_type(4)));
constexpr int BM = 256, BK = 64, HALF = 128, HTB = HALF * BK * 2  , STAGE_BYTES = 8 * HTB, NXCD = 8, WGM = 4;

__host__ __device__ __forceinline__ int lds_byte(int r, int c) { const int st = (r >> 4) * 2 + (c >> 5), rr = r & 15, cc = c & 31, ob = rr * 64 + cc * 2; return st * 1024 + (ob ^ (((ob >> 9) & 1) << 5)); }
__host__ __device__ __forceinline__ void stage_rc(int b, int& R, int& C) { const int st = b / 1024, sb = b % 1024, swz = sb ^ (((sb >> 9) & 1) << 5); R = (st >> 1) * 16 + swz / 64; C = (st & 1) * 32 + (swz % 64) / 2; }
__host__ __device__ __forceinline__ int perm32(int rho) { const int n = rho >> 4, i = rho & 15; return 8 * (i >> 2) + 4 * n + (i & 3); }

struct Unit { int pm, pn; };
struct Gemm { const bf16_t* A; const bf16_t* Bt; int M, N, K; };

struct StaticOrder {
    int nM, nN, nwg, G, c;
    __host__ __device__ void init(int M, int N, int G_, int c_) { nM = M / BM; nN = N / BM; nwg = nM * nN; G = G_; c = c_; }
    __host__ __device__ bool next(int i, Unit& u) const {
        const long L = (long)i * G + c; if (L >= nwg) return false;
        int wgid = (int)L; { const int q = nwg / NXCD, r = nwg % NXCD, xcd = wgid % NXCD, off = wgid / NXCD; wgid = (xcd < r ? xcd * (q + 1) : r * (q + 1) + (xcd - r) * q) + off; }
        const int nig = WGM * nN, gid = wgid / nig, fm = gid * WGM, gsz = (nM - fm) < WGM ? (nM - fm) : WGM;
        u.pm = fm + ((wgid % nig) % gsz); u.pn = (wgid % nig) / gsz; return true;
    }
    __device__ __forceinline__ void a_ready(const Unit&) const {}
    __device__ __forceinline__ void done(const Unit&) const {}
};

__device__ __forceinline__ unsigned cvt_pk_bf16(float lo, float hi) { unsigned r; asm volatile("v_cvt_pk_bf16_f32 %0, %1, %2" : "=v"(r) : "v"(lo), "v"(hi)); return r; }
__device__ __forceinline__ float sum_x16(float s) { auto r = __builtin_amdgcn_permlane16_swap(__float_as_uint(s), __float_as_uint(s), false, false); return __uint_as_float(r[0]) + __uint_as_float(r[1]); }
__device__ __forceinline__ float sum_x32(float s) { auto r = __builtin_amdgcn_permlane32_swap(__float_as_uint(s), __float_as_uint(s), false, false); return __uint_as_float(r[0]) + __uint_as_float(r[1]); }
__device__ __forceinline__ float peer_x16(float v, int fq) { auto r = __builtin_amdgcn_permlane16_swap(__float_as_uint(v), __float_as_uint(v), false, false); return __uint_as_float((fq & 1) ? r[0] : r[1]); }
constexpr float C2Q = 0.125f * 1.4426950408889634f;
__device__ __forceinline__ float row_rstd(const float* part, int row, int fq) {
    const float* pp = part + (size_t)(4 * fq) * 65536 + row; const f32x4 p = {pp[0], pp[65536], pp[2 * 65536], pp[3 * 65536]};
    float s = (p[0] + p[1]) + (p[2] + p[3]);
    s = sum_x16(s); s = sum_x32(s);
    return __builtin_amdgcn_rsqf(s * (1.0f / 1024.0f) + 1e-6f);
}
__device__ __forceinline__ void rows_part_load(const float* part, int row0  , int fq, f32x4 (&pl)[2][4]) {
#pragma unroll
    for (int ai = 0; ai < 2; ++ai)
#pragma unroll
        for (int m = 0; m < 4; ++m) { const float* pp = part + (size_t)(4 * fq) * 65536 + (row0 + ai * HALF + m * 16);
            pl[ai][m] = (f32x4){pp[0], pp[65536], pp[2 * 65536], pp[3 * 65536]}; }
}
__device__ __forceinline__ void rows_part_reduce(const f32x4 (&pl)[2][4], float (&rs)[2][4]) {
#pragma unroll
    for (int ai = 0; ai < 2; ++ai)
#pragma unroll
        for (int m = 0; m < 4; ++m) { float s = (pl[ai][m][0] + pl[ai][m][1]) + (pl[ai][m][2] + pl[ai][m][3]); s = sum_x16(s); s = sum_x32(s); rs[ai][m] = __builtin_amdgcn_rsqf(s * (1.0f / 1024.0f) + 1e-6f); }
}
__device__ __forceinline__ void rows_rstd(const float* part, int row0, int fq, float (&rs)[2][4]) { f32x4 pl[2][4]; rows_part_load(part, row0, fq, pl); rows_part_reduce(pl, rs); }
struct EpiProj {
    static constexpr bool PERM = true, AFTER_DRAIN = false, NEEDS_RSTD = true;
    bf16_t* proj; int ldp; const float* part; const float* cs; bf16_t* vt; bf16_t* kd; int odd;
    __device__ __forceinline__ void operator()(const f32x4 (&acc)[2][2][4][2], const Unit& u, int wr, int wc, int fr, int fq, PG8_LAS float* stash, int par, PG8_LAS unsigned char* stg, const Unit& un) const {
        const bool newpm = (un.pm != u.pm);
        f32x4 pln[2][4]; if (newpm) rows_part_load(part, un.pm * BM + wr * 64 + fr, fq, pln);
        float rsa[2][4];
#pragma unroll
        for (int ai = 0; ai < 2; ++ai)
#pragma unroll
            for (int m = 0; m < 4; ++m) rsa[ai][m] = stash[par * 256 + ai * HALF + wr * 64 + m * 16 + fr];
#pragma unroll
        for (int ai = 0; ai < 2; ++ai)
#pragma unroll
            for (int m = 0; m < 4; ++m) {
                if (m == 0) asm volatile("" ::: "memory");
                const int row = u.pm * BM + ai * HALF + wr * 64 + m * 16 + fr, pos = row & 4095, b = row >> 12;
                const float rs = rsa[ai][m];
#pragma unroll
                for (int bj = 0; bj < 2; ++bj) {
                    int kind;
                    if (odd) kind = (u.pn < 6) ? 0 : (u.pn == 6 ? 1 : 2);
                    else     kind = (u.pn < 2) ? 0 : (u.pn == 2 ? (wc < 2 ? 1 : 2) : 3);
                    float v[8];
#pragma unroll
                    for (int i = 0; i < 4; ++i) { v[i] = acc[ai][bj][m][0][i] * rs; v[4 + i] = acc[ai][bj][m][1][i] * rs; }
                    if (kind <= 1 && bj == 0) {
                        const f32x4 c0 = *(const f32x4*)(cs + pos * 16), c1 = *(const f32x4*)(cs + pos * 16 + 4), s0 = *(const f32x4*)(cs + pos * 16 + 8), s1 = *(const f32x4*)(cs + pos * 16 + 12);
#pragma unroll
                        for (int i = 0; i < 8; ++i) {
                            const float c = i < 4 ? c0[i & 3] : c1[i & 3], s = i < 4 ? s0[i & 3] : s1[i & 3];
                            const float pr = peer_x16(v[i], fq);
                            const float r = (fq == 0) ? (v[i] * c - pr * s) : (v[i] * c + pr * s);
                            v[i] = (fq < 2) ? r : v[i];
                        }
                    }
                    if (kind == 0) {
#pragma unroll
                        for (int i = 0; i < 8; ++i) v[i] *= C2Q;
                    }
                    { u32x4 w; w.x = cvt_pk_bf16(v[0], v[1]); w.y = cvt_pk_bf16(v[2], v[3]); w.z = cvt_pk_bf16(v[4], v[5]); w.w = cvt_pk_bf16(v[6], v[7]);
                      *(PG8_LAS u32x4*)(stg + fr * 144 + fq * 16 + bj * 64) = w; }
                }
                {
                    int kind;
                    if (odd) kind = (u.pn < 6) ? 0 : (u.pn == 6 ? 1 : 2);
                    else     kind = (u.pn < 2) ? 0 : (u.pn == 2 ? (wc < 2 ? 1 : 2) : 3);
#pragma unroll
                    for (int i = 0; i < 2; ++i) { const int c = fq * 16 + fr + 64 * i, rr = c >> 3, pc = c & 7;
                        const u32x4 w = *(const PG8_LAS u32x4*)(stg + rr * 144 + pc * 16);
                        const int rowc = row - fr + rr, posc = rowc & 4095;
                        if (kind == 1 || kind == 2) {
                            bf16_t* dst = (kind == 1) ? kd : vt;
                            if (odd) *(u32x4*)(dst + (size_t)(b * 4 + wc) * (4096 * 64) + (size_t)((posc & 15) * 256 + (posc >> 4)) * 64 + pc * 8) = w;
                            else     *(u32x4*)(dst + (size_t)(b * 2 + (wc & 1)) * (4096 * 64) + (size_t)posc * 64 + pc * 8) = w;
                        } else {
                            *(u32x4*)(proj + (size_t)rowc * ldp + u.pn * BM + wc * 64 + pc * 8) = w;
                        }
                    }
                }
            }
        if (newpm) { float rsn[2][4]; rows_part_reduce(pln, rsn);
          if (fq == 0) {
#pragma unroll
              for (int ai = 0; ai < 2; ++ai)
#pragma unroll
                  for (int m = 0; m < 4; ++m) stash[(par ^ 1) * 256 + ai * HALF + wr * 64 + m * 16 + fr] = rsn[ai][m]; } }
    }
};
struct EpiRes {
    static constexpr bool PERM = true, AFTER_DRAIN = false, NEEDS_RSTD = false;
    bf16_t* xb; float* part; bf16_t* xo_; float* po_;
    __device__ __forceinline__ void operator()(const f32x4 (&acc)[2][2][4][2], const Unit& u, int wr, int wc, int fr, int fq, PG8_LAS unsigned char* stg) const {
        const int lane = fq * 16 + fr;
        const size_t colw = (size_t)u.pn * BM + wc * 64;
        const int rowb = u.pm * BM + wr * 64;
        PG8_LAS unsigned char* st = stg + fr * 144 + fq * 16;
#pragma unroll
        for (int ai = 0; ai < 2; ++ai) {
        asm volatile("" ::: "memory");
        u32x4 xin[4][2];
#pragma unroll
        for (int m = 0; m < 4; ++m)
#pragma unroll
            for (int i = 0; i < 2; ++i) { const int c = lane + 64 * i; xin[m][i] = *(const u32x4*)(xb + (size_t)(rowb + ai * HALF + m * 16 + (c >> 3)) * 1024 + colw + (c & 7) * 8); }
#pragma unroll
        for (int m = 0; m < 4; ++m) {
            const int row = rowb + ai * HALF + m * 16 + fr;
#pragma unroll
            for (int i = 0; i < 2; ++i) { const int c = lane + 64 * i; *(PG8_LAS u32x4*)(stg + (c >> 3) * 144 + (c & 7) * 16) = xin[m][i]; }
            float ss = 0.f;
#pragma unroll
            for (int bj = 0; bj < 2; ++bj) {
                const u32x4 xo = *(const PG8_LAS u32x4*)(st + bj * 64);
                float v[8];
#pragma unroll
                for (int i = 0; i < 4; ++i) { v[2 * i] = __uint_as_float(xo[i] << 16) + acc[ai][bj][m][i >> 1][(2 * i) & 3]; v[2 * i + 1] = __uint_as_float(xo[i] & 0xffff0000u) + acc[ai][bj][m][i >> 1][(2 * i + 1) & 3]; }
                u32x4 w; w.x = cvt_pk_bf16(v[0], v[1]); w.y = cvt_pk_bf16(v[2], v[3]); w.z = cvt_pk_bf16(v[4], v[5]); w.w = cvt_pk_bf16(v[6], v[7]);
                *(PG8_LAS u32x4*)(st + bj * 64) = w;
                ss += ((v[0] * v[0] + v[1] * v[1]) + (v[2] * v[2] + v[3] * v[3])) + ((v[4] * v[4] + v[5] * v[5]) + (v[6] * v[6] + v[7] * v[7]));
            }
#pragma unroll
            for (int i = 0; i < 2; ++i) { const int c = lane + 64 * i; const u32x4 w = *(const PG8_LAS u32x4*)(stg + (c >> 3) * 144 + (c & 7) * 16);
                *(u32x4*)(xo_ + (size_t)(row - fr + (c >> 3)) * 1024 + colw + (c & 7) * 8) = w; }
            ss = sum_x16(ss); ss = sum_x32(ss);
            if (fq == 0) po_[(size_t)(u.pn * 4 + wc) * 65536 + row] = ss;
        }
        }
    }
};
struct EpiUp {
    static constexpr bool PERM = true, AFTER_DRAIN = false, NEEDS_RSTD = true;
    bf16_t* uo; const float* part;
    __device__ __forceinline__ void operator()(const f32x4 (&acc)[2][2][4][2], const Unit& u, int wr, int wc, int fr, int fq, PG8_LAS float* stash, int par, PG8_LAS unsigned char* stg, const Unit& un) const {
        const bool newpm = (un.pm != u.pm);
        f32x4 pln[2][4]; if (newpm) rows_part_load(part, un.pm * BM + wr * 64 + fr, fq, pln);
        float rsa[2][4];
#pragma unroll
        for (int ai = 0; ai < 2; ++ai)
#pragma unroll
            for (int m = 0; m < 4; ++m) rsa[ai][m] = stash[par * 256 + ai * HALF + wr * 64 + m * 16 + fr];
#pragma unroll
        for (int ai = 0; ai < 2; ++ai)
#pragma unroll
            for (int m = 0; m < 4; ++m) {
                const int row = u.pm * BM + ai * HALF + wr * 64 + m * 16 + fr;
                const float rs = rsa[ai][m];
                PG8_LAS unsigned char* st = stg + fr * 144 + fq * 16;
#pragma unroll
                for (int bj = 0; bj < 2; ++bj) {
                    float v[8];
#pragma unroll
                    for (int i = 0; i < 4; ++i) { v[i] = acc[ai][bj][m][0][i] * rs; v[4 + i] = acc[ai][bj][m][1][i] * rs; }
#pragma unroll
                    for (int i = 0; i < 8; ++i) { const float r = fmaxf(v[i], 0.f); v[i] = r * r; }
                    u32x4 w; w.x = cvt_pk_bf16(v[0], v[1]); w.y = cvt_pk_bf16(v[2], v[3]); w.z = cvt_pk_bf16(v[4], v[5]); w.w = cvt_pk_bf16(v[6], v[7]);
                    *(PG8_LAS u32x4*)(st + bj * 64) = w;
                }
#pragma unroll
                for (int i = 0; i < 2; ++i) { const int c = fq * 16 + fr + 64 * i, rr = c >> 3, pc = c & 7;
                    const u32x4 w = *(const PG8_LAS u32x4*)(stg + rr * 144 + pc * 16);
                    __builtin_nontemporal_store(w, (u32x4*)(uo + (size_t)(row - fr + rr) * 4096 + u.pn * BM + wc * 64 + pc * 8)); }
            }
        if (newpm) { float rsn[2][4]; rows_part_reduce(pln, rsn);
          if (fq == 0) {
#pragma unroll
              for (int ai = 0; ai < 2; ++ai)
#pragma unroll
                  for (int m = 0; m < 4; ++m) stash[(par ^ 1) * 256 + ai * HALF + wr * 64 + m * 16 + fr] = rsn[ai][m]; } }
    }
};
template <class Epi, class Sched, bool ALIGN_EPI = false, bool SP2 = false>
__device__ __forceinline__ void gemm_phase(PG8_LAS unsigned char* lds, const Gemm g, const Sched& S, const Epi& E, const int wave_s) {
    int tid_o; asm volatile("v_mbcnt_lo_u32_b32 %0, -1, 0\n\tv_mbcnt_hi_u32_b32 %0, -1, %0" : "=v"(tid_o)); tid_o += wave_s * 64;
    const int tid = tid_o, wid = __builtin_amdgcn_readfirstlane(tid >> 6), lane = tid & 63, wr = wid >> 2, wc = wid & 3, fr = lane & 15, fq = lane >> 4;
    const int K = g.K, nt = K / BK;
    unsigned voffA[2], voffB[2];
#pragma unroll
    for (int i = 0; i < 2; ++i) { int R, C; stage_rc(tid * 16 + i * 8192, R, C); const int Rb = Epi::PERM ? ((R >> 5) * 64 + perm32(R & 31)) : R;
        voffA[i] = (unsigned)(R * K + C) * 2u; voffB[i] = (unsigned)(Rb * K + C) * 2u; }
    const size_t kstep = (size_t)(BK * 2);
    const size_t hstep = (size_t)HALF * K * 2;
    const size_t bhstep = Epi::PERM ? (size_t)32 * K * 2 : hstep;
    const size_t tstep = 2 * hstep;
    const unsigned ldsw = (unsigned)wid * 1024u;
    const int aoff = lds_byte(wr * 64 + fr, fq * 8), boff = lds_byte(wc * 32 + fr, fq * 8);
#define PG8_SA(b, h) (((b) * 2 + (h)) * HTB)
#define PG8_SB(b, h) ((4 + (b) * 2 + (h)) * HTB)
#define PG8_STAGE(bufoff, gbase, voff) do { _Pragma("unroll") for (int _i = 0; _i < 2; ++_i) \
        __builtin_amdgcn_global_load_lds((const unsigned*)((const char*)(gbase) + (voff)[_i]), (PG8_LAS unsigned*)(lds + (bufoff) + ldsw + _i * 8192), 16, 0, 0); } while (0)
#define PG8_LDA(dst, b, h) do { _Pragma("unroll") for (int m = 0; m < 4; ++m) _Pragma("unroll") for (int k = 0; k < 2; ++k) dst[m][k] = *(const PG8_LAS bf16x8*)(lds + PG8_SA(b, h) + aoff + m * 2048 + k * 1024); } while (0)
#define PG8_LDB(dst, b, h) do { _Pragma("unroll") for (int n = 0; n < 2; ++n) _Pragma("unroll") for (int k = 0; k < 2; ++k) dst[n][k] = *(const PG8_LAS bf16x8*)(lds + PG8_SB(b, h) + boff + n * 2048 + k * 1024); } while (0)
#define PG8_MMA(ai, bj, At, Bt) do { __builtin_amdgcn_s_setprio(1); _Pragma("unroll") for (int m = 0; m < 4; ++m) _Pragma("unroll") for (int n = 0; n < 2; ++n) _Pragma("unroll") for (int k = 0; k < 2; ++k) \
        acc[ai][bj][m][n] = __builtin_amdgcn_mfma_f32_16x16x32_bf16(Bt[n][k], At[m][k], acc[ai][bj][m][n], 0, 0, 0); __builtin_amdgcn_s_setprio(0); } while (0)
#define PG8_WAIT_V(n) asm volatile("s_waitcnt vmcnt(" #n ")" ::: "memory")
#define PG8_WAIT_L(n) asm volatile("s_waitcnt lgkmcnt(" #n ")" ::: "memory")
#define PG8_BAR __builtin_amdgcn_s_barrier()
#define PG8_SCHED __builtin_amdgcn_sched_barrier(0)
    Unit cur, nxt; int ui = 0;
    if (!S.next(0, cur)) return;
    PG8_LAS float* rs_stash = (PG8_LAS float*)(lds + STAGE_BYTES); int rs_par = 0;
    if constexpr (Epi::NEEDS_RSTD) { float rs0[2][4]; rows_rstd(E.part, cur.pm * BM + wr * 64 + fr, fq, rs0);
        if (fq == 0) {
#pragma unroll
            for (int ai = 0; ai < 2; ++ai)
#pragma unroll
                for (int m = 0; m < 4; ++m) rs_stash[ai * HALF + wr * 64 + m * 16 + fr] = rs0[ai][m]; } }
    f32x4 acc[2][2][4][2];
#pragma unroll
    for (int a = 0; a < 2; ++a)
#pragma unroll
        for (int b = 0; b < 2; ++b)
#pragma unroll
            for (int m = 0; m < 4; ++m)
#pragma unroll
                for (int n = 0; n < 2; ++n) acc[a][b][m][n] = (f32x4){0.f, 0.f, 0.f, 0.f};
    bf16x8 At[4][2], B0[2][2], B1[2][2];
    const char* cA = (const char*)g.A + (size_t)cur.pm * tstep; const char* cB = (const char*)g.Bt + (size_t)cur.pn * tstep;
    S.a_ready(cur);
    if constexpr (SP2) {
        PG8_STAGE(PG8_SB(0, 0), cB, voffB); PG8_STAGE(PG8_SB(0, 1), cB + bhstep, voffB); PG8_STAGE(PG8_SA(0, 0), cA, voffA); PG8_STAGE(PG8_SA(0, 1), cA + hstep, voffA);
        if (wr == 1) PG8_BAR;
        PG8_WAIT_V(2); PG8_BAR;
        PG8_STAGE(PG8_SB(1, 0), cB + kstep, voffB); PG8_STAGE(PG8_SA(1, 0), cA + kstep, voffA); PG8_STAGE(PG8_SB(1, 1), cB + bhstep + kstep, voffB);
        PG8_WAIT_V(6); PG8_BAR;
    } else {
        PG8_STAGE(PG8_SB(0, 0), cB, voffB); PG8_STAGE(PG8_SA(0, 0), cA, voffA); PG8_STAGE(PG8_SB(0, 1), cB + bhstep, voffB); PG8_STAGE(PG8_SA(0, 1), cA + hstep, voffA);
        if (wr == 1) PG8_BAR;
        PG8_WAIT_V(4); PG8_BAR;
        PG8_STAGE(PG8_SB(1, 0), cB + kstep, voffB); PG8_STAGE(PG8_SA(1, 0), cA + kstep, voffA); PG8_STAGE(PG8_SB(1, 1), cB + bhstep + kstep, voffB);
        PG8_WAIT_V(6); PG8_BAR;
    }
    for (;;) {
        const bool has_next = S.next(ui + 1, nxt);
        const char* nA = has_next ? (const char*)g.A + (size_t)nxt.pm * tstep : cA; const char* nB = has_next ? (const char*)g.Bt + (size_t)nxt.pn * tstep : cB;
        for (int t = 0; t < nt; t += 2) {
            const bool last = (t == nt - 2);
            const char* a1 = cA + (size_t)(t + 1) * kstep;
            const char* a2 = last ? nA : cA + (size_t)(t + 2) * kstep; const char* b2 = last ? nB : cB + (size_t)(t + 2) * kstep;
            const char* a3 = a2 + kstep; const char* b3 = b2 + kstep;
            if (last && has_next) S.a_ready(nxt);
            if constexpr (SP2) {
            PG8_LDB(B0, 0, 0); PG8_LDB(B1, 0, 1); PG8_SCHED; PG8_LDA(At, 0, 0); PG8_STAGE(PG8_SA(1, 1), a1 + hstep, voffA);
            PG8_WAIT_V(8); PG8_WAIT_L(0); PG8_BAR; PG8_MMA(0, 0, At, B0); PG8_MMA(0, 1, At, B1); PG8_BAR; PG8_SCHED;
            PG8_LDA(At, 0, 1); PG8_STAGE(PG8_SB(0, 0), b2, voffB); PG8_STAGE(PG8_SB(0, 1), b2 + bhstep, voffB); PG8_STAGE(PG8_SA(0, 0), a2, voffA);
            PG8_WAIT_V(8); PG8_WAIT_L(0); PG8_BAR; PG8_MMA(1, 0, At, B0); PG8_MMA(1, 1, At, B1); PG8_BAR; PG8_SCHED;
            PG8_LDB(B0, 1, 0); PG8_LDB(B1, 1, 1); PG8_SCHED; PG8_LDA(At, 1, 0); PG8_STAGE(PG8_SA(0, 1), a2 + hstep, voffA);
            PG8_WAIT_V(8); PG8_WAIT_L(0); PG8_BAR; PG8_MMA(0, 0, At, B0); PG8_MMA(0, 1, At, B1); PG8_BAR; PG8_SCHED;
            PG8_LDA(At, 1, 1); PG8_STAGE(PG8_SB(1, 0), b3, voffB); PG8_STAGE(PG8_SB(1, 1), b3 + bhstep, voffB); PG8_STAGE(PG8_SA(1, 0), a3, voffA);
            PG8_WAIT_V(8); PG8_WAIT_L(0); PG8_BAR; PG8_MMA(1, 0, At, B0); PG8_MMA(1, 1, At, B1); PG8_BAR; PG8_SCHED;
            } else {
            PG8_LDB(B0, 0, 0); PG8_SCHED; PG8_LDA(At, 0, 0); PG8_STAGE(PG8_SA(1, 1), a1 + hstep, voffA);
            PG8_WAIT_L(8); PG8_BAR; PG8_WAIT_L(0); PG8_MMA(0, 0, At, B0); PG8_BAR; PG8_SCHED;
            PG8_LDB(B1, 0, 1); PG8_STAGE(PG8_SB(0, 0), b2, voffB);
            PG8_BAR; PG8_WAIT_L(0); PG8_MMA(0, 1, At, B1); PG8_BAR;
            PG8_LDA(At, 0, 1); PG8_STAGE(PG8_SA(0, 0), a2, voffA);
            PG8_BAR; PG8_WAIT_L(0); PG8_MMA(1, 0, At, B0); PG8_BAR; PG8_SCHED;
            PG8_STAGE(PG8_SB(0, 1), b2 + bhstep, voffB);
            PG8_WAIT_V(6); PG8_BAR; PG8_MMA(1, 1, At, B1); PG8_BAR;
            PG8_LDB(B0, 1, 0); PG8_SCHED; PG8_LDA(At, 1, 0); PG8_STAGE(PG8_SA(0, 1), a2 + hstep, voffA);
            PG8_WAIT_L(8); PG8_BAR; PG8_WAIT_L(0); PG8_MMA(0, 0, At, B0); PG8_BAR; PG8_SCHED;
            PG8_LDB(B1, 1, 1); PG8_STAGE(PG8_SB(1, 0), b3, voffB);
            PG8_BAR; PG8_WAIT_L(0); PG8_MMA(0, 1, At, B1); PG8_BAR;
            PG8_LDA(At, 1, 1); PG8_STAGE(PG8_SA(1, 0), a3, voffA);
            PG8_BAR; PG8_WAIT_L(0); PG8_MMA(1, 0, At, B0); PG8_BAR; PG8_SCHED;
            PG8_STAGE(PG8_SB(1, 1), b3 + bhstep, voffB);
            PG8_WAIT_V(6); PG8_BAR; PG8_MMA(1, 1, At, B1); PG8_BAR;
            }
        }
        if constexpr (ALIGN_EPI) { if (wr == 0) PG8_BAR; }
        if constexpr (!Epi::AFTER_DRAIN) { if constexpr (Epi::NEEDS_RSTD) E(acc, cur, wr, wc, fr, fq, rs_stash, rs_par, (PG8_LAS unsigned char*)(lds + STAGE_BYTES + 2048 + wid * 2304), has_next ? nxt : cur); else E(acc, cur, wr, wc, fr, fq, (PG8_LAS unsigned char*)(lds + STAGE_BYTES + 2048 + wid * 2304)); S.done(cur); }
        if (!has_next) break;
#pragma unroll
        for (int a = 0; a < 2; ++a)
#pragma unroll
            for (int b = 0; b < 2; ++b)
#pragma unroll
                for (int m = 0; m < 4; ++m)
#pragma unroll
                    for (int n = 0; n < 2; ++n) acc[a][b][m][n] = (f32x4){0.f, 0.f, 0.f, 0.f};
        if (nxt.pm != cur.pm) rs_par ^= 1;
        cur = nxt; cA = nA; cB = nB; ++ui;
        if constexpr (ALIGN_EPI) { if (wr == 1) PG8_BAR; }
    }
    PG8_WAIT_V(0);
    if constexpr (!ALIGN_EPI) { if (wr == 0) PG8_BAR; }
    PG8_BAR;
    if constexpr (Epi::AFTER_DRAIN) { E.fused(acc, cur, wr, wc, fr, fq, lds, wid, lane); S.done(cur); }
#undef PG8_SA
#undef PG8_SB
#undef PG8_STAGE
#undef PG8_LDA
#undef PG8_LDB
#undef PG8_MMA
#undef PG8_WAIT_V
#undef PG8_WAIT_L
#undef PG8_BAR
#undef PG8_SCHED
}
}
#define LAS __attribute__((address_space(3)))
typedef pg8::bf16_t bf16_t;
typedef short bf16x8 __attribute__((ext_vector_type(8)));
typedef float f32x4 __attribute__((ext_vector_type(4)));
typedef float f32x16 __attribute__((ext_vector_type(16)));
typedef unsigned u32x4 __attribute__((ext_vector_type(4)));
typedef unsigned u32x2 __attribute__((ext_vector_type(2)));

constexpr int NTOK = 65536, DM = 1024, SEQ = 4096, NB = 16, DFF = 4096;
constexpr int NWAVES = 8, NTHREADS = 512;
constexpr int LDS_BYTES = 131072, LDS_ALLOC = 163840, WAVE_LDS = 20480, MISC_OFF = LDS_ALLOC - 256;
constexpr size_t MiB = (size_t)1 << 20;
constexpr size_t WS_WIN_E = 0, WS_WOUT_E = 5 * MiB, WS_WIN_O = 9 * MiB, WS_WOUT_O = 17 * MiB, WS_WUP = 19 * MiB, WS_WDN = 51 * MiB;
constexpr size_t WS_WF = 83 * MiB, WS_CS = 87 * MiB, WS_PART = 88 * MiB, WS_BAR = 92 * MiB, WS_LSE = 93 * MiB, WS_XB = 96 * MiB, WS_BIG = 224 * MiB;
constexpr size_t WS_PROJ = WS_BIG, WS_VT = WS_BIG + 256 * MiB, WS_MIX = WS_BIG + 352 * MiB, WS_KD = WS_BIG + 480 * MiB, WS_U = WS_BIG, WS_END = WS_BIG + 576 * MiB;

struct Params {
    const float *x, *norm_mix, *norm_mlp, *norm_final, *w_in_even, *w_out_even, *sink, *w_pool, *pool_scale, *w_in_odd, *w_out_odd, *w_up, *w_down;
    float* out; unsigned char* ws;
};

__device__ __forceinline__ unsigned pk2(float lo, float hi) { return pg8::cvt_pk_bf16(lo, hi); }
__device__ __forceinline__ float wave_sum(float v) {
#pragma unroll
    for (int o = 1; o < 64; o <<= 1) v += __shfl_xor(v, o);
    return v;
}

#define XB_TMO      128
#define XB_XCNT(j)  (256  + 64 * (j))
#define XB_XSUB(j)  (1280 + 64 * (j))
#define XB_XGEN(j)  (2304 + 64 * (j))
#define XB_TOP      3328
#define XB_TOPGEN   3392
#define XCD_BAR_WORDS 3456
#define XB_SPIN_CAP (1u << 22)
__device__ __forceinline__ unsigned xb_ld(unsigned* p)              { return __hip_atomic_load(p, __ATOMIC_RELAXED, __HIP_MEMORY_SCOPE_AGENT); }
__device__ __forceinline__ unsigned xb_add(unsigned* p, unsigned v) { return __hip_atomic_fetch_add(p, v, __ATOMIC_RELAXED, __HIP_MEMORY_SCOPE_AGENT); }
__device__ __forceinline__ unsigned xb_xcc_id() { return (unsigned)__builtin_amdgcn_s_getreg((3 << 11) | 20) & 0xFu; }
#define XB_SPIN(cond, bar) do { unsigned _sp = 0; while (cond) { __builtin_amdgcn_s_sleep(1); \
    if ((++_sp & 255u) == 0u) { if (xb_ld(&(bar)[XB_TMO])) break; if (_sp > XB_SPIN_CAP) { atomicAdd(&(bar)[XB_TMO], 1u); break; } } } } while (0)
struct XcdBarrier { unsigned* bar; unsigned x; volatile LAS unsigned* st; };
__device__ __forceinline__ bool wg_leader(int wave) { int ln; asm volatile("v_mbcnt_lo_u32_b32 %0, -1, 0\n\tv_mbcnt_hi_u32_b32 %0, -1, %0" : "=v"(ln)); return wave == 0 && ln == 0; }
__device__ __forceinline__ XcdBarrier xcd_barrier_post(unsigned* bar, volatile LAS unsigned* st, int wave) {
    XcdBarrier b; b.bar = bar; b.x = xb_xcc_id(); b.st = st;
    if (wg_leader(wave)) (void)xb_add(&bar[XB_XCNT(b.x)], 1u);
    return b;
}
__device__ __forceinline__ void xcd_barrier_complete(unsigned* bar, unsigned x, unsigned& nloc, unsigned& nx) {
    const unsigned G = gridDim.x * gridDim.y * gridDim.z;
    unsigned sum, cnt, mine, sp = 0u;
    for (;;) {
        sum = 0u; cnt = 0u; mine = 0u;
#pragma unroll
        for (unsigned j = 0; j < 16; ++j) { const unsigned c = xb_ld(&bar[XB_XCNT(j)]); sum += c; cnt += (c > 0u) ? 1u : 0u; mine = (j == x) ? c : mine; }
        if (sum == G) break;
        __builtin_amdgcn_s_sleep(1);
        if ((++sp & 255u) == 0u) { if (xb_ld(&bar[XB_TMO])) break; if (sp > XB_SPIN_CAP) { atomicAdd(&bar[XB_TMO], 1u); break; } }
    }
    nloc = mine > 0u ? mine : 1u; nx = cnt > 0u ? cnt : 1u;
}
__device__ __forceinline__ void xcd_barrier(const XcdBarrier& b, int wave) {
    asm volatile("s_waitcnt vmcnt(0)" ::: "memory");
    __syncthreads();
    if (wg_leader(wave)) {
        unsigned* bar = b.bar;
        __builtin_amdgcn_s_waitcnt(0);
        unsigned nloc = b.st[0], nx = b.st[1];
        if (nloc == 0u) { xcd_barrier_complete(bar, b.x, nloc, nx); b.st[0] = nloc; b.st[1] = nx; }
        const unsigned old = xb_add(&bar[XB_XSUB(b.x)], 1u);
        const unsigned gen = old / nloc;
        if (old + 1u == (gen + 1u) * nloc) {
            __builtin_amdgcn_fence(__ATOMIC_RELEASE, "agent");
            asm volatile("s_waitcnt vmcnt(0)" ::: "memory");
            const unsigned og = xb_add(&bar[XB_TOP], 1u);
            const unsigned tg = og / nx;
            if (og + 1u == (tg + 1u) * nx) xb_add(&bar[XB_TOPGEN], 1u);
            else XB_SPIN(xb_ld(&bar[XB_TOPGEN]) == tg, bar);
            __builtin_amdgcn_fence(__ATOMIC_ACQUIRE, "agent");
            xb_add(&bar[XB_XGEN(b.x)], 1u);
            asm volatile("s_waitcnt vmcnt(0)" ::: "memory");
        } else {
            XB_SPIN(xb_ld(&bar[XB_XGEN(b.x)]) == gen, bar);
            __builtin_amdgcn_fence(__ATOMIC_ACQUIRE, "agent");
            asm volatile("s_waitcnt vmcnt(0)" ::: "memory");
        }
    }
    __syncthreads();
}

__device__ __forceinline__ void transpose_item(const float* W, const float* gain, int N, bf16_t* WT, int ldk, int koff, LAS float* scr, int item, int lane) {
    const int nblk = N / 32, kb = item / nblk, nb = item % nblk, k0 = 64 * kb, n0 = 32 * nb;
    const int c4 = lane & 7, kr = lane >> 3;
#pragma unroll
    for (int i = 0; i < 8; ++i) { const int kk = 8 * i + kr; const float g = gain ? gain[k0 + kk] : 1.f; const f32x4 v = *(const f32x4*)(W + (size_t)(k0 + kk) * N + n0 + 4 * c4);
        LAS float* d = scr + kk * 33 + 4 * c4; d[0] = v[0] * g; d[1] = v[1] * g; d[2] = v[2] * g; d[3] = v[3] * g; }
    asm volatile("s_waitcnt lgkmcnt(0)" ::: "memory");
    const int c = lane & 7;
#pragma unroll
    for (int j = 0; j < 4; ++j) { const int n = (lane >> 3) + 8 * j; const LAS float* s = scr + (8 * c) * 33 + n;
        u32x4 o; o.x = pk2(s[0 * 33], s[1 * 33]); o.y = pk2(s[2 * 33], s[3 * 33]); o.z = pk2(s[4 * 33], s[5 * 33]); o.w = pk2(s[6 * 33], s[7 * 33]);
        *(u32x4*)(WT + (size_t)(n0 + n) * ldk + koff + k0 + 8 * c) = o; }
    asm volatile("s_waitcnt lgkmcnt(0)" ::: "memory");
}
struct Job { const float* W; const float* g; int Kr, N; bf16_t* WT; int ldk, koff; };
__device__ __forceinline__ Job get_job(const Params& p, int j) {
    Job J; unsigned char* ws = p.ws;
    if (j < 6) { const int e = j / 3, t = j % 3;
        if (t == 0) { J.W = p.w_in_even + (size_t)e * 1024 * 1280; J.g = p.norm_mix + (2 * e) * 1024; J.Kr = 1024; J.N = 1280; J.WT = (bf16_t*)(ws + WS_WIN_E) + (size_t)e * 1280 * 1024; J.ldk = 1024; J.koff = 0; }
        else if (t == 1) { J.W = p.w_out_even + (size_t)e * 1024 * 1024; J.g = nullptr; J.Kr = 512; J.N = 1024; J.WT = (bf16_t*)(ws + WS_WOUT_E) + (size_t)e * 1024 * 1024; J.ldk = 1024; J.koff = 0; }
        else { J.W = p.w_out_even; J.g = nullptr; J.Kr = 0; J.N = 1024; J.WT = (bf16_t*)(ws + WS_WOUT_E) + (size_t)e * 1024 * 1024; J.ldk = 1024; J.koff = 512; }
    } else if (j < 10) { const int o = (j - 6) / 2, t = (j - 6) % 2;
        if (t == 0) { J.W = p.w_in_odd + (size_t)o * 1024 * 2048; J.g = p.norm_mix + (2 * o + 1) * 1024; J.Kr = 1024; J.N = 2048; J.WT = (bf16_t*)(ws + WS_WIN_O) + (size_t)o * 2048 * 1024; J.ldk = 1024; J.koff = 0; }
        else { J.W = p.w_out_odd + (size_t)o * 512 * 1024; J.g = nullptr; J.Kr = 512; J.N = 1024; J.WT = (bf16_t*)(ws + WS_WOUT_O) + (size_t)o * 1024 * 512; J.ldk = 512; J.koff = 0; }
    } else { const int l = (j - 10) / 2, t = (j - 10) % 2;
        if (t == 0) { J.W = p.w_up + (size_t)l * 1024 * 4096; J.g = p.norm_mlp + l * 1024; J.Kr = 1024; J.N = 4096; J.WT = (bf16_t*)(ws + WS_WUP) + (size_t)l * 4096 * 1024; J.ldk = 1024; J.koff = 0; }
        else { J.W = p.w_down + (size_t)l * 4096 * 1024; J.g = nullptr; J.Kr = 4096; J.N = 1024; J.WT = (bf16_t*)(ws + WS_WDN) + (size_t)l * 1024 * 4096; J.ldk = 4096; J.koff = 0; }
    }
    return J;
}
constexpr int NJOBS = 18;

__device__ __forceinline__ void sincos_d(float a, float& c, float& s) {
    const double x = (double)a; const double k = __builtin_rint(x * 0.63661977236758134308);
    const double r = x - k * 1.57079632679489661923; const double r2 = r * r;
    double sp = -1.0 / 1307674368000.0; sp = sp * r2 + 1.0 / 6227020800.0; sp = sp * r2 - 1.0 / 39916800.0; sp = sp * r2 + 1.0 / 362880.0; sp = sp * r2 - 1.0 / 5040.0; sp = sp * r2 + 1.0 / 120.0; sp = sp * r2 - 1.0 / 6.0; sp = sp * r2 + 1.0;
    const double sn = sp * r;
    double cp = 1.0 / 20922789888000.0; cp = cp * r2 - 1.0 / 87178291200.0; cp = cp * r2 + 1.0 / 479001600.0; cp = cp * r2 - 1.0 / 3628800.0; cp = cp * r2 + 1.0 / 40320.0; cp = cp * r2 - 1.0 / 720.0; cp = cp * r2 + 1.0 / 24.0; cp = cp * r2 - 0.5; cp = cp * r2 + 1.0;
    const int q = ((int)k) & 3;
    const double cc = (q == 0) ? cp : (q == 1) ? -sn : (q == 2) ? -cp : sn;
    const double ss = (q == 0) ? sn : (q == 1) ? cp : (q == 2) ? -sn : -cp;
    c = (float)cc; s = (float)ss;
}

struct KVFrag { bf16x8 kr[4]; bf16x8 vr[4]; };
__device__ __forceinline__ void load_frags(KVFrag& f, const bf16_t* K0, const bf16_t* V0, int kb, int mode, int rsel, int lane) {
    if (mode == 0) {
        const int eo = kb * 64 + lane * 8;
        const bf16_t* kp = K0 + eo; const bf16_t* vp = V0 + eo;
#pragma unroll
        for (int i = 0; i < 4; ++i) { f.kr[i] = *(const bf16x8*)(kp + 512 * i); f.vr[i] = *(const bf16x8*)(vp + 512 * i); }
    } else if (mode == 1) {
        const int k0 = lane >> 3;
        const int eo = ((((k0 & 3) * 4 + rsel) * 256) + (kb >> 2) + (k0 >> 2)) * 64 + (lane & 7) * 8;
        const bf16_t* kp = K0 + eo; const bf16_t* vp = V0 + eo;
#pragma unroll
        for (int i = 0; i < 4; ++i) { f.kr[i] = *(const bf16x8*)(kp + 128 * i); f.vr[i] = *(const bf16x8*)(vp + 128 * i); }
    } else {
        const int k0 = lane >> 3;
        const int eo = (k0 * 256 + (kb >> 4)) * 64 + (lane & 7) * 8;
        const bf16_t* kp = K0 + eo; const bf16_t* vp = V0 + eo;
#pragma unroll
        for (int i = 0; i < 4; ++i) { const int o = (i & 1) * (8 * 256 * 64) + (i >> 1) * 64; f.kr[i] = *(const bf16x8*)(kp + o); f.vr[i] = *(const bf16x8*)(vp + o); }
    }
}
typedef short s16x4 __attribute__((ext_vector_type(4)));
constexpr int KST_OFF = 6144, KST_RS = 144;
constexpr int VST_RS = 192;
struct HState { f32x16 o[2]; float m, l; };
__device__ __forceinline__ void stage_v(const KVFrag& f, LAS unsigned char* vst, int lane, int hi, bf16x8 (&vf)[2][2], bf16x8 (&kf)[4]) {
#pragma unroll
    for (int i = 0; i < 4; ++i) { const int c = lane + 64 * i; *(LAS bf16x8*)(vst + (c >> 3) * VST_RS + (c & 7) * 16) = f.vr[i]; *(LAS bf16x8*)(vst + KST_OFF + (c >> 3) * KST_RS + (c & 7) * 16) = f.kr[i]; }
    const LAS unsigned char* tb = vst + (8 * hi + ((lane & 15) >> 2)) * VST_RS + (16 * ((lane >> 4) & 1) + 4 * (lane & 3)) * 2;
#pragma unroll
    for (int ks = 0; ks < 2; ++ks)
#pragma unroll
        for (int dh = 0; dh < 2; ++dh) {
            const s16x4 lo = __builtin_bit_cast(s16x4, __builtin_amdgcn_ds_read_tr16_b64_v4i16((LAS s16x4*)(tb + (16 * ks) * VST_RS + dh * 64)));
            const s16x4 hi4 = __builtin_bit_cast(s16x4, __builtin_amdgcn_ds_read_tr16_b64_v4i16((LAS s16x4*)(tb + (16 * ks + 4) * VST_RS + dh * 64)));
            vf[ks][dh] = (bf16x8){lo[0], lo[1], lo[2], lo[3], hi4[0], hi4[1], hi4[2], hi4[3]};
        }
    const int l31 = lane & 31, jsw = (l31 & 0x13) | ((l31 & 4) << 1) | ((l31 & 8) >> 1);
    const LAS unsigned char* kb_ = vst + KST_OFF + jsw * KST_RS + 16 * hi;
#pragma unroll
    for (int d0 = 0; d0 < 4; ++d0) kf[d0] = *(const LAS bf16x8*)(kb_ + 32 * d0);
}
struct ORows { unsigned base_row, pstride, amask, ashift, ld, hcol; };
__device__ __forceinline__ unsigned orow_off(const ORows& R, int rr) { return (R.base_row + R.pstride * ((unsigned)rr & R.amask)) * R.ld + R.hcol + 64u * ((unsigned)rr >> R.ashift); }
constexpr int QST_RS = 144, QST_SET = 32 * QST_RS;
__device__ __forceinline__ void qk_tile(const bf16x8 (&kf)[4], const LAS unsigned char* qh, f32x16& s) {
    const f32x16 z = {0.f, 0.f, 0.f, 0.f, 0.f, 0.f, 0.f, 0.f, 0.f, 0.f, 0.f, 0.f, 0.f, 0.f, 0.f, 0.f};
    s = __builtin_amdgcn_mfma_f32_32x32x16_bf16(kf[0], *(const LAS bf16x8*)qh, z, 0, 0, 0);
#pragma unroll
    for (int d0 = 1; d0 < 4; ++d0) s = __builtin_amdgcn_mfma_f32_32x32x16_bf16(kf[d0], *(const LAS bf16x8*)(qh + 32 * d0), s, 0, 0, 0);
}
__device__ __forceinline__ void q_rows_load(const bf16_t* proj, const ORows& R, int lane, u32x4 (&qv)[4]) {
#pragma unroll
    for (int i = 0; i < 4; ++i) { const int c = lane + 64 * i; qv[i] = *(const u32x4*)(proj + (orow_off(R, c >> 3) + (unsigned)((c & 7) * 8))); }
}
__device__ __forceinline__ void q_rows_stage(const u32x4 (&qv)[4], LAS unsigned char* qset, int lane) {
#pragma unroll
    for (int i = 0; i < 4; ++i) { const int c = lane + 64 * i; *(LAS u32x4*)(qset + (c >> 3) * QST_RS + (c & 7) * 16) = qv[i]; }
}
__device__ __forceinline__ float max3f(float a, float b, float c) { return fmaxf(fmaxf(a, b), c); }
__device__ __forceinline__ float max2f(float a, float b) { return fmaxf(a, b); }
typedef float f32x2 __attribute__((ext_vector_type(2)));
typedef __bf16 bf16x2_t __attribute__((ext_vector_type(2)));
__device__ __forceinline__ unsigned cvtpk_s(float lo, float hi) { f32x2 v = {lo, hi}; bf16x2_t b = __builtin_convertvector(v, bf16x2_t); return __builtin_bit_cast(unsigned, b); }
__device__ __forceinline__ void softmax_head(f32x16& s, int kb, int lq, int radius, bool full, int hi, HState& S) {
    if (!full) {
#pragma unroll
        for (int r = 0; r < 16; ++r) { const int lk = kb + 16 * (r >> 3) + 8 * hi + (r & 7); const int d = lk - lq;
            const bool valid = (unsigned)(d + radius) <= (unsigned)(2 * radius); s[r] = valid ? s[r] : -INFINITY; }
    }
    float t0 = max3f(s[0], s[1], s[2]), t1 = max3f(s[3], s[4], s[5]);
    t0 = max3f(t0, s[6], s[7]); t1 = max3f(t1, s[8], s[9]); t0 = max3f(t0, s[10], s[11]); t1 = max3f(t1, s[12], s[13]);
    float tmax = max3f(t0, s[14], s[15]); tmax = max2f(tmax, t1);
    { auto rr = __builtin_amdgcn_permlane32_swap(__float_as_uint(tmax), __float_as_uint(tmax), false, false); tmax = max2f(__uint_as_float(rr[0]), __uint_as_float(rr[1])); }
    if (__builtin_amdgcn_ballot_w64(tmax > S.m + 8.0f) != 0ull) {
        const float mn = max2f(S.m, tmax), alpha = __builtin_amdgcn_exp2f(S.m - mn); S.m = mn; S.l *= alpha;
#pragma unroll
        for (int dh = 0; dh < 2; ++dh)
#pragma unroll
            for (int r = 0; r < 16; ++r) S.o[dh][r] *= alpha;
    }
}
__device__ __forceinline__ void softmax_tail(f32x16& s, HState& S, u32x4 (&pw)[2]) {
    const float mn = S.m;
#pragma unroll
    for (int r = 0; r < 16; ++r) s[r] -= mn;
#pragma unroll
    for (int r = 0; r < 16; ++r) s[r] = __builtin_amdgcn_exp2f(s[r]);
    float p0 = s[0], p1 = s[1];
#pragma unroll
    for (int r = 2; r < 16; r += 2) { p0 += s[r]; p1 += s[r + 1]; }
    S.l += p0 + p1;
#pragma unroll
    for (int ks = 0; ks < 2; ++ks) { pw[ks].x = cvtpk_s(s[8 * ks + 0], s[8 * ks + 1]); pw[ks].y = cvtpk_s(s[8 * ks + 2], s[8 * ks + 3]); pw[ks].z = cvtpk_s(s[8 * ks + 4], s[8 * ks + 5]); pw[ks].w = cvtpk_s(s[8 * ks + 6], s[8 * ks + 7]); }
}
__device__ __forceinline__ void softmax_tile(f32x16& s, int kb, int lq, int radius, bool full, int hi, HState& S, u32x4 (&pw)[2]) { softmax_head(s, kb, lq, radius, full, hi, S); softmax_tail(s, S, pw); }
#define MFMA_VALU_INTERLEAVE() do { _Pragma("unroll") for (int g_ = 0; g_ < 4; ++g_) { __builtin_amdgcn_sched_group_barrier(0x008, 1, 0); __builtin_amdgcn_sched_group_barrier(0x002, 14, 0); } } while (0)
#ifndef XTRA_MFMA
#define XTRA_MFMA 0
#endif
__device__ __forceinline__ void pv_tile(const bf16x8 (&vf)[2][2], const u32x4 (&pw)[2], HState& S) {
#pragma unroll
    for (int ks = 0; ks < 2; ++ks)
#pragma unroll
        for (int dh = 0; dh < 2; ++dh) S.o[dh] = __builtin_amdgcn_mfma_f32_32x32x16_bf16(vf[ks][dh], __builtin_bit_cast(bf16x8, pw[ks]), S.o[dh], 0, 0, 0);
    if (XTRA_MFMA) {
        u32x4 zz = {0u, 0u, 0u, 0u}; asm volatile("" : "+v"(zz));
#pragma unroll
        for (int k = 0; k < XTRA_MFMA; ++k) S.o[k & 1] = __builtin_amdgcn_mfma_f32_32x32x16_bf16(vf[0][k & 1], __builtin_bit_cast(bf16x8, zz), S.o[k & 1], 0, 0, 0);
    }
}
struct QSet { int lq, lqmin, lqmax; };
template <int NH>
__device__ __forceinline__ void tile_all(const KVFrag& f, const LAS unsigned char* ql, LAS unsigned char* vst, int lane, int hi, int kb, int radius, const QSet& qa, const QSet& qb, HState& A, HState& B) {
    bf16x8 vf[2][2], kf[4]; stage_v(f, vst, lane, hi, vf, kf);
    f32x16 sa; u32x4 pwa[2];
    qk_tile(kf, ql, sa);
    if (NH == 1) {
        softmax_tile(sa, kb, qa.lq, radius, (kb >= qa.lqmax - radius) && (kb + 31 <= qa.lqmin + radius), hi, A, pwa);
        pv_tile(vf, pwa, A);
    } else {
        f32x16 sb; u32x4 pwb[2];
        softmax_head(sa, kb, qa.lq, radius, (kb >= qa.lqmax - radius) && (kb + 31 <= qa.lqmin + radius), hi, A);
        __builtin_amdgcn_sched_barrier(0);
        qk_tile(kf, ql + QST_SET, sb);
        softmax_tail(sa, A, pwa);
        MFMA_VALU_INTERLEAVE();
        __builtin_amdgcn_sched_barrier(0);
        softmax_head(sb, kb, qb.lq, radius, (kb >= qb.lqmax - radius) && (kb + 31 <= qb.lqmin + radius), hi, B);
        __builtin_amdgcn_sched_barrier(0);
        pv_tile(vf, pwa, A);
        softmax_tail(sb, B, pwb);
        MFMA_VALU_INTERLEAVE();
        __builtin_amdgcn_sched_barrier(0);
        pv_tile(vf, pwb, B);
    }
}
template <int NH>
__device__ __forceinline__ void attn_pass(const LAS unsigned char* ql, LAS unsigned char* vst, int lane, const bf16_t* K0, const bf16_t* V0, int mode, int rsel, int L, int kb0, int nt, int radius,
                                          const QSet& qa, const QSet& qb, HState& A, HState& B) {
    const int lane31 = lane & 31, hi = lane >> 5;
    const int jsw = (lane31 & 0x13) | ((lane31 & 4) << 1) | ((lane31 & 8) >> 1);
    const int ilo = kb0 < 0 ? ((-kb0) >> 5) : 0, ihi = min(nt, (L - kb0) >> 5);
    if (ilo >= ihi) return;
    KVFrag fa, fb;
    load_frags(fa, K0, V0, kb0 + 32 * ilo, mode, rsel, lane);
    int i = ilo;
    for (; i + 1 < ihi; i += 2) {
        const int kb = kb0 + 32 * i;
        __builtin_amdgcn_sched_barrier(0);
        load_frags(fb, K0, V0, kb + 32, mode, rsel, lane);
        tile_all<NH>(fa, ql, vst, lane, hi, kb, radius, qa, qb, A, B);
        __builtin_amdgcn_sched_barrier(0);
        load_frags(fa, K0, V0, kb0 + 32 * min(i + 2, ihi - 1), mode, rsel, lane);
        tile_all<NH>(fb, ql, vst, lane, hi, kb + 32, radius, qa, qb, A, B);
    }
    __builtin_amdgcn_sched_barrier(0);
    if (i < ihi) tile_all<NH>(fa, ql, vst, lane, hi, kb0 + 32 * i, radius, qa, qb, A, B);
}
constexpr int OST_RS = 144;
__device__ __forceinline__ void orows_put(const f32x16 (&o)[2], float sc, LAS unsigned char* stg, int lane) {
    const int q = lane & 31, hi = lane >> 5;
#pragma unroll
    for (int dh = 0; dh < 2; ++dh)
#pragma unroll
        for (int g = 0; g < 4; ++g) { u32x2 w; w.x = pk2(o[dh][4 * g] * sc, o[dh][4 * g + 1] * sc); w.y = pk2(o[dh][4 * g + 2] * sc, o[dh][4 * g + 3] * sc);
            *(LAS u32x2*)(stg + q * OST_RS + (32 * dh + 8 * g + 4 * hi) * 2) = w; }
}
__device__ __forceinline__ void orows_store(LAS unsigned char* stg, bf16_t* mix, const ORows& R, int lane) {
#pragma unroll
    for (int i = 0; i < 4; ++i) { const int c = lane + 64 * i, rr = c >> 3, pc = c & 7;
        const u32x4 v = *(const LAS u32x4*)(stg + rr * OST_RS + pc * 16);
        *(u32x4*)(mix + (orow_off(R, rr) + (unsigned)(pc * 8))) = v; }
}
__device__ __forceinline__ void attn_store(const HState& S, bf16_t* mix, const ORows& R, LAS unsigned char* stg, int lane) {
    float l = pg8::sum_x32(S.l);
    orows_put(S.o, 1.0f / l, stg, lane);
    orows_store(stg, mix, R, lane);
}
__device__ __forceinline__ void attn_store_lse(const HState& S, bf16_t* mix, const ORows& R, LAS unsigned char* stg, float* lsep, int lane) {
    float l = pg8::sum_x32(S.l);
    orows_put(S.o, 1.0f / l, stg, lane);
    orows_store(stg, mix, R, lane);
    if ((lane >> 5) == 0) *lsep = S.m + __builtin_amdgcn_logf(l);
}
__device__ __forceinline__ void attn_store_merge(const HState& S, bf16_t* mix, const ORows& R, LAS unsigned char* stg, const float* lsep, int lane) {
    const int q = lane & 31, hi = lane >> 5;
    u32x4 xr[4];
#pragma unroll
    for (int i = 0; i < 4; ++i) { const int c = lane + 64 * i; xr[i] = *(const u32x4*)(mix + (orow_off(R, c >> 3) + (unsigned)((c & 7) * 8))); }
    float l = pg8::sum_x32(S.l);
    const float lx = *lsep, M = fmaxf(S.m, lx), wy = __builtin_amdgcn_exp2f(S.m - M), wx = __builtin_amdgcn_exp2f(lx - M);
    const float inv = 1.0f / (wy * l + wx), ay = wy * inv, ax = wx * inv;
#pragma unroll
    for (int i = 0; i < 4; ++i) { const int c = lane + 64 * i; *(LAS u32x4*)(stg + (c >> 3) * OST_RS + (c & 7) * 16) = xr[i]; }
#pragma unroll
    for (int dh = 0; dh < 2; ++dh)
#pragma unroll
        for (int g = 0; g < 4; ++g) { LAS u32x2* slot = (LAS u32x2*)(stg + q * OST_RS + (32 * dh + 8 * g + 4 * hi) * 2); const u32x2 old = *slot;
            u32x2 w; w.x = pk2(S.o[dh][4 * g] * ay + __uint_as_float(old.x << 16) * ax, S.o[dh][4 * g + 1] * ay + __uint_as_float(old.x & 0xffff0000u) * ax);
            w.y = pk2(S.o[dh][4 * g + 2] * ay + __uint_as_float(old.y << 16) * ax, S.o[dh][4 * g + 3] * ay + __uint_as_float(old.y & 0xffff0000u) * ax);
            *slot = w; }
    orows_store(stg, mix, R, lane);
}
__device__ __forceinline__ void hstate_init(HState& S, float m, float l) {
#pragma unroll
    for (int r = 0; r < 16; ++r) { S.o[0][r] = 0.f; S.o[1][r] = 0.f; }
    S.m = m; S.l = l;
}

__device__ __forceinline__ void attn_even_unit(int uid, const bf16_t* proj, const bf16_t* kd, const bf16_t* vd, bf16_t* mix, const float* sink, int lane, LAS bf16x8* qlds  , LAS unsigned char* vst) {
    asm volatile("v_mbcnt_lo_u32_b32 %0, -1, 0\n\tv_mbcnt_hi_u32_b32 %0, -1, %0" : "=v"(lane));
    const int qt = uid & 127, kvh = (uid >> 7) & 1, b = uid >> 8;
    const int q0 = qt * 32;
    const bf16_t* K0 = kd + (size_t)(b * 2 + kvh) * (4096 * 64);
    const bf16_t* V0 = vd + (size_t)(b * 2 + kvh) * (4096 * 64);
    for (int hp = 0; hp < 2; ++hp) {
        const int h0 = kvh * 4 + hp * 2;
        asm volatile("v_mbcnt_lo_u32_b32 %0, -1, 0\n\tv_mbcnt_hi_u32_b32 %0, -1, %0" : "=v"(lane));
        const int lane31 = lane & 31, hi = lane >> 5, t = q0 + lane31; const QSet qs{t, q0, q0 + 31};
        { u32x4 qa_[4], qb_[4];
          const ORows Ra{(unsigned)(b * SEQ + q0), 1u, 31u, 5u, 1280u, (unsigned)(h0 * 64)}, Rb{(unsigned)(b * SEQ + q0), 1u, 31u, 5u, 1280u, (unsigned)((h0 + 1) * 64)};
          q_rows_load(proj, Ra, lane, qa_); q_rows_load(proj, Rb, lane, qb_);
          q_rows_stage(qa_, (LAS unsigned char*)qlds, lane); q_rows_stage(qb_, (LAS unsigned char*)qlds + QST_SET, lane); }
        HState A, B;
        hstate_init(A, sink[h0] * 1.4426950408889634f, (hi == 0) ? 1.f : 0.f); hstate_init(B, sink[h0 + 1] * 1.4426950408889634f, (hi == 0) ? 1.f : 0.f);
        attn_pass<2>((const LAS unsigned char*)qlds + lane31 * QST_RS + 16 * hi, vst, lane, K0, V0, 0, 0, SEQ, q0 - 128, 9, 128, qs, qs, A, B);
        asm volatile("v_mbcnt_lo_u32_b32 %0, -1, 0\n\tv_mbcnt_hi_u32_b32 %0, -1, %0" : "=v"(lane));
        { const ORows R{(unsigned)(b * SEQ + q0), 1u, 31u, 5u, 1024u, (unsigned)(h0 * 64)}; attn_store(A, mix, R, vst, lane); }
        { const ORows R{(unsigned)(b * SEQ + q0), 1u, 31u, 5u, 1024u, (unsigned)((h0 + 1) * 64)}; attn_store(B, mix, R, vst, lane); }
    }
}
__device__ __forceinline__ void attn_x_unit(int uid, const bf16_t* proj, const bf16_t* kd, const bf16_t* vd, bf16_t* mix, float* lse, int lane, LAS bf16x8* qlds, LAS unsigned char* vst) {
    asm volatile("v_mbcnt_lo_u32_b32 %0, -1, 0\n\tv_mbcnt_hi_u32_b32 %0, -1, %0" : "=v"(lane));
    const int qt = uid & 127, kvh = (uid >> 7) & 3, b = uid >> 9, lane31 = lane & 31, hi = lane >> 5;
    const int q0 = qt * 32, t = q0 + lane31; const size_t row = (size_t)b * SEQ + t;
    const bf16_t* K0 = kd + (size_t)(b * 4 + kvh) * (4096 * 64);
    const bf16_t* V0 = vd + (size_t)(b * 4 + kvh) * (4096 * 64);
    const QSet qs{t, q0, q0 + 31};
    { u32x4 qa_[4], qb_[4];
      const ORows Ra{(unsigned)(b * SEQ + q0), 1u, 31u, 5u, 2048u, (unsigned)((kvh * 2) * 64)}, Rb{(unsigned)(b * SEQ + q0), 1u, 31u, 5u, 2048u, (unsigned)((kvh * 2 + 1) * 64)};
      q_rows_load(proj, Ra, lane, qa_); q_rows_load(proj, Rb, lane, qb_);
      q_rows_stage(qa_, (LAS unsigned char*)qlds, lane); q_rows_stage(qb_, (LAS unsigned char*)qlds + QST_SET, lane); }
    HState A, B; hstate_init(A, -1e30f, 0.f); hstate_init(B, -1e30f, 0.f);
    attn_pass<2>((const LAS unsigned char*)qlds + lane31 * QST_RS + 16 * hi, vst, lane, K0, V0, 2, 0, SEQ, q0 - 64, 5, 64, qs, qs, A, B);
    { const ORows R{(unsigned)(b * SEQ + q0), 1u, 31u, 5u, 512u, (unsigned)((kvh * 2) * 64)}; attn_store_lse(A, mix, R, vst, lse + (size_t)(kvh * 2) * NTOK + row, lane); }
    { const ORows R{(unsigned)(b * SEQ + q0), 1u, 31u, 5u, 512u, (unsigned)((kvh * 2 + 1) * 64)}; attn_store_lse(B, mix, R, vst, lse + (size_t)(kvh * 2 + 1) * NTOK + row, lane); }
}
__device__ __forceinline__ void attn_odd_unit(int uid, const bf16_t* proj, const bf16_t* kd, const bf16_t* vd, bf16_t* mix, const float* lse, int lane, LAS bf16x8* qlds, LAS unsigned char* vst) {
    asm volatile("v_mbcnt_lo_u32_b32 %0, -1, 0\n\tv_mbcnt_hi_u32_b32 %0, -1, %0" : "=v"(lane));
    const int rp = uid & 7, lt = (uid >> 3) & 15, kvh = (uid >> 7) & 3, b = uid >> 9, lane31 = lane & 31, hi = lane >> 5;
    const int rA = (rp & 3) + 8 * (rp >> 2), rB = rA + 4;
    const int j = lane31 >> 4, a = lane31 & 15, l0 = lt * 16, tA = rA + 16 * (l0 + a); const size_t rowA = (size_t)b * SEQ + tA, rowB = rowA + 4;
    HState A, B; hstate_init(A, -1e30f, 0.f); hstate_init(B, -1e30f, 0.f);
    const size_t LAY = (size_t)16 * 256 * 4096;
    const size_t bk = (size_t)(b * 4 + kvh) * (4096 * 64);
#pragma unroll
    for (int g = 1; g < 3; ++g) {
        const int D = (g == 0) ? 1 : (g == 1 ? 4 : 16), s = 16 / D, L = SEQ / D, nt = (g == 0) ? 12 : (g == 1 ? 6 : 5);
        const int head = g * 8 + kvh * 2 + j;
        { u32x4 qa_[4], qb_[4];
          const ORows Ra{(unsigned)(b * SEQ + rA + 16 * l0), 16u, 15u, 4u, 2048u, (unsigned)((g * 8 + kvh * 2) * 64)}, Rb{(unsigned)(b * SEQ + rB + 16 * l0), 16u, 15u, 4u, 2048u, (unsigned)((g * 8 + kvh * 2) * 64)};
          q_rows_load(proj, Ra, lane, qa_); q_rows_load(proj, Rb, lane, qb_);
          q_rows_stage(qa_, (LAS unsigned char*)qlds, lane); q_rows_stage(qb_, (LAS unsigned char*)qlds + QST_SET, lane); }
        const int cA = rA / D, cB = rB / D;
        const QSet qa{cA + s * (l0 + a), cA + s * l0, cA + s * (l0 + 15)}, qb{cB + s * (l0 + a), cB + s * l0, cB + s * (l0 + 15)};
        const int kb0 = (s * l0 - 64) & ~31;
        if (g < 2) {
            attn_pass<2>((const LAS unsigned char*)qlds + lane31 * QST_RS + 16 * hi, vst, lane, kd + bk, vd + bk, 1, rA & 3, L, kb0, nt, 64, qa, qb, A, B);
        } else {
            attn_pass<1>((const LAS unsigned char*)qlds + lane31 * QST_RS + 16 * hi, vst, lane, kd + bk + (size_t)(rA * L) * 64, vd + bk + (size_t)(rA * L) * 64, 0, 0, L, kb0, nt, 64, qa, qa, A, A);
            attn_pass<1>((const LAS unsigned char*)qlds + lane31 * QST_RS + 16 * hi + QST_SET, vst, lane, kd + bk + (size_t)(rB * L) * 64, vd + bk + (size_t)(rB * L) * 64, 0, 0, L, kb0, nt, 64, qb, qb, B, B);
        }
    }
    { const ORows R{(unsigned)(b * SEQ + rA + 16 * l0), 16u, 15u, 4u, 512u, (unsigned)((kvh * 2) * 64)}; attn_store_merge(A, mix, R, vst, lse + (size_t)(kvh * 2 + j) * NTOK + rowA, lane); }
    { const ORows R{(unsigned)(b * SEQ + rB + 16 * l0), 16u, 15u, 4u, 512u, (unsigned)((kvh * 2) * 64)}; attn_store_merge(B, mix, R, vst, lse + (size_t)(kvh * 2 + j) * NTOK + rowB, lane); }
}
__device__ __forceinline__ void bf8_unpack(const u32x4 v, float (&f)[8]) {
#pragma unroll
    for (int i = 0; i < 4; ++i) { f[2 * i] = __uint_as_float(v[i] << 16); f[2 * i + 1] = __uint_as_float(v[i] & 0xffff0000u); }
}
__device__ __forceinline__ void pool_rows32(int row0, const bf16_t* proj, bf16_t* mix, int lane) {
    const int t0 = row0 & 4095, w2 = 1 << (lane >> 4);
    const bf16_t* base = proj + (size_t)(row0 - t0) * 1280 + 768 + 8 * lane;
    float S[8];
#pragma unroll
    for (int i = 0; i < 8; ++i) S[i] = 0.f;
    {
        u32x4 v[16];
#pragma unroll
        for (int k = 0; k < 16; ++k) { const int off = k - 8, tt = t0 + off; const bool ok = (off >= -w2) && (off < w2) && (tt >= 0) && (tt < SEQ);
            v[k] = (u32x4){0u, 0u, 0u, 0u}; if (ok) v[k] = *(const u32x4*)(base + (unsigned)tt * 1280u); }
#pragma unroll
        for (int k = 0; k < 16; ++k) { float f[8]; bf8_unpack(v[k], f);
#pragma unroll
            for (int i = 0; i < 8; ++i) S[i] += f[i]; }
    }
#pragma unroll 1
    for (int rb = 0; rb < 32; rb += 8) {
        u32x4 ve[8], vl[8], vc[8];
#pragma unroll
        for (int r = 0; r < 8; ++r) { const int t = t0 + rb + r, te = t + w2, tl = t - w2;
            vc[r] = *(const u32x4*)(base + (unsigned)t * 1280u);
            ve[r] = (u32x4){0u, 0u, 0u, 0u}; if (te < SEQ) ve[r] = *(const u32x4*)(base + (unsigned)te * 1280u);
            vl[r] = (u32x4){0u, 0u, 0u, 0u}; if (tl >= 0) vl[r] = *(const u32x4*)(base + (unsigned)tl * 1280u); }
#pragma unroll
        for (int r = 0; r < 8; ++r) { const int t = t0 + rb + r, lo = max(t - w2, 0), hi = min(t + w2, SEQ);
            const float inv = 1.0f / (float)(hi - lo);
            float c[8], d[8]; bf8_unpack(vc[r], c);
#pragma unroll
            for (int i = 0; i < 8; ++i) d[i] = S[i] * inv - c[i];
            u32x4 w; w.x = pk2(d[0], d[1]); w.y = pk2(d[2], d[3]); w.z = pk2(d[4], d[5]); w.w = pk2(d[6], d[7]);
            *(u32x4*)(mix + (size_t)(row0 + rb + r) * 1024 + 512 + 8 * lane) = w;
            float e[8], l[8]; bf8_unpack(ve[r], e); bf8_unpack(vl[r], l);
#pragma unroll
            for (int i = 0; i < 8; ++i) S[i] += e[i] - l[i]; }
    }
}

__global__ void __launch_bounds__(NTHREADS, 2) fwd_megakernel(Params p) {
    extern __shared__ __attribute__((aligned(16))) unsigned char lds_raw[];
    cg::grid_group grid = cg::this_grid();
    LAS unsigned char* lds = (LAS unsigned char*)lds_raw;
    const int tid = threadIdx.x, lane = tid & 63, wave = __builtin_amdgcn_readfirstlane(tid >> 6);
    const int G = gridDim.x, bx = blockIdx.x;
    const int gw = bx * NWAVES + wave, NGW = G * NWAVES;
    const int vb = (G % 8 == 0) ? (bx % 8) * (G / 8) + bx / 8 : bx;
    unsigned char* ws = p.ws;
    bf16_t* XB = (bf16_t*)(ws + WS_XB); bf16_t* PROJ = (bf16_t*)(ws + WS_PROJ); bf16_t* VT = (bf16_t*)(ws + WS_VT); bf16_t* MIX = (bf16_t*)(ws + WS_MIX); bf16_t* KD = (bf16_t*)(ws + WS_KD); bf16_t* UB = (bf16_t*)(ws + WS_U);
    float* PART = (float*)(ws + WS_PART); float* LSE = (float*)(ws + WS_LSE); float* CS = (float*)(ws + WS_CS); float* WF = (float*)(ws + WS_WF);

    volatile LAS unsigned* MISC = (volatile LAS unsigned*)(lds + MISC_OFF);
    if (tid < 4) MISC[tid] = 0u;
    unsigned* BAR = (unsigned*)(ws + WS_BAR);
    if (bx == 0) for (int i = tid; i < XCD_BAR_WORDS; i += NTHREADS) BAR[i] = 0u;
    __syncthreads();
#ifndef REP_PRO
#define REP_PRO 1
#endif
    for (int rep_p = 0; rep_p < REP_PRO; ++rep_p)
    {
        const int gt = bx * NTHREADS + tid, NT = G * NTHREADS;
        for (int u = gw; u < 2048; u += NGW) {
            const int nb = u & 15, k8 = (u >> 4) & 15, g = (u >> 8) & 3, e = u >> 10, n = nb * 64 + lane, k0 = k8 * 8;
            const float* wp = p.w_pool + ((size_t)(e * 4 + g) * 128 + k0) * 128; const float* sc = p.pool_scale + e * 512 + g * 128;
            const float* wo = p.w_out_even + ((size_t)e * 1024 + 512 + g * 128) * 1024 + n;
            float acc[8];
#pragma unroll
            for (int i = 0; i < 8; ++i) acc[i] = 0.f;
#pragma unroll 16
            for (int jj = 0; jj < 128; ++jj) { const float w = wo[(size_t)jj * 1024] * sc[jj];
#pragma unroll
                for (int i = 0; i < 8; ++i) acc[i] += wp[i * 128 + jj] * w; }
            u32x4 o; o.x = pk2(acc[0], acc[1]); o.y = pk2(acc[2], acc[3]); o.z = pk2(acc[4], acc[5]); o.w = pk2(acc[6], acc[7]);
            *(u32x4*)((bf16_t*)(ws + WS_WOUT_E) + (size_t)e * 1024 * 1024 + (size_t)n * 1024 + 512 + g * 128 + k0) = o;
        }
        for (int idx = gt; idx < SEQ * 8; idx += NT) {
            const int i = idx & 7, pos = idx >> 3;
            const float inv = (i == 0) ? 1.0f : (i == 1) ? 0.1939227432012558f : (i == 2) ? 0.03760603070259094f : (i == 3) ? 0.007292664609849453f : (i == 4) ? 0.0014142135623842478f : (i == 5) ? 0.00027424818836152554f : (i == 6) ? 5.3182957344688475e-05f : 1.0313385246263351e-05f;
            float c, s; sincos_d((float)pos * inv, c, s);
            CS[pos * 16 + i] = c; CS[pos * 16 + 8 + i] = s;
        }
        {
            LAS float* scr = (LAS float*)(lds + wave * 16384);
            int itbase = 0;
            for (int jb = 0; jb < NJOBS; ++jb) {
                const Job J = get_job(p, jb); const int nitems = (J.Kr / 64) * (J.N / 32);
                const int first = (gw - (itbase % NGW) + NGW) % NGW;
                for (int it = first; it < nitems; it += NGW) transpose_item(J.W, J.g, J.N, J.WT, J.ldk, J.koff, scr, it, lane);
                itbase += nitems;
            }
        }
        for (int r0 = gw * 4; r0 < NTOK; r0 += NGW * 4) {
            f32x4 v[4][4];
#pragma unroll
            for (int q = 0; q < 4; ++q) { const f32x4* xr = (const f32x4*)(p.x + (size_t)(r0 + q) * DM) + lane;
#pragma unroll
                for (int jj = 0; jj < 4; ++jj) v[q][jj] = xr[64 * jj]; }
            float ssq[4];
#pragma unroll
            for (int q = 0; q < 4; ++q) { float ss = 0.f; unsigned long long* o8 = (unsigned long long*)(XB + (size_t)(r0 + q) * DM) + lane;
#pragma unroll
                for (int jj = 0; jj < 4; ++jj) { ss += (v[q][jj][0] * v[q][jj][0] + v[q][jj][1] * v[q][jj][1]) + (v[q][jj][2] * v[q][jj][2] + v[q][jj][3] * v[q][jj][3]);
                    o8[64 * jj] = (unsigned long long)pk2(v[q][jj][0], v[q][jj][1]) | ((unsigned long long)pk2(v[q][jj][2], v[q][jj][3]) << 32); }
                ssq[q] = wave_sum(ss); }
            { const int sl = lane >= 60 ? 0 : 1 + (lane >> 2), qq = lane >= 60 ? lane - 60 : (lane & 3);
              const float val = lane >= 60 ? (qq == 0 ? ssq[0] : qq == 1 ? ssq[1] : qq == 2 ? ssq[2] : ssq[3]) : 0.f;
              PART[(size_t)sl * NTOK + r0 + qq] = val; }
        }
    }
    grid.sync();
    const XcdBarrier xbar = xcd_barrier_post(BAR, MISC, wave);
#define GRID_BAR() xcd_barrier(xbar, wave)
#ifndef XBAR_EXTRA
#define XBAR_EXTRA 0
#endif
    for (int xs = 0; xs < XBAR_EXTRA; ++xs) GRID_BAR();

    for (int layer = 0; layer < 4; ++layer) {
        const int odd = layer & 1, li = layer >> 1;
        {
            const int N = odd ? 2048 : 1280;
            const bf16_t* Wt = odd ? (const bf16_t*)(ws + WS_WIN_O) + (size_t)li * 2048 * 1024 : (const bf16_t*)(ws + WS_WIN_E) + (size_t)li * 1280 * 1024;
            pg8::Gemm g{XB, Wt, NTOK, N, 1024}; pg8::StaticOrder S; S.init(NTOK, N, G, bx);
            pg8::EpiProj E{PROJ, N, PART, CS, VT, KD, odd};
#ifndef REP_IN
#define REP_IN 1
#endif
            for (int rep = 0; rep < REP_IN; ++rep)
            pg8::gemm_phase<pg8::EpiProj, pg8::StaticOrder, true, true>(lds, g, S, E, wave);
        }
        GRID_BAR();
#ifndef REP_ATTN_E
#define REP_ATTN_E 1
#endif
#ifndef REP_ATTN_O
#define REP_ATTN_O 1
#endif
        for (int rep = 0; rep < (odd ? REP_ATTN_O : REP_ATTN_E); ++rep) {
        int lane_o; asm volatile("v_mbcnt_lo_u32_b32 %0, -1, 0\n\tv_mbcnt_hi_u32_b32 %0, -1, %0" : "=v"(lane_o)); const int gwv = vb * NWAVES + wave;
        if (odd) {
#ifndef REP_X
#define REP_X 1
#endif
            for (int rq = 0; rq < REP_X; ++rq)
            for (int uid = gwv; uid < 8192; uid += NGW) attn_x_unit(uid, PROJ, KD, VT, MIX, LSE, lane_o, (LAS bf16x8*)(lds + wave * WAVE_LDS), lds + wave * WAVE_LDS + 2 * QST_SET);
            GRID_BAR();
            int lane_y; asm volatile("v_mbcnt_lo_u32_b32 %0, -1, 0\n\tv_mbcnt_hi_u32_b32 %0, -1, %0" : "=v"(lane_y));
            for (int uid = gwv; uid < 8192; uid += NGW) attn_odd_unit(uid, PROJ, KD, VT, MIX, LSE, lane_y, (LAS bf16x8*)(lds + wave * WAVE_LDS), lds + wave * WAVE_LDS + 2 * QST_SET);
        } else {
#ifndef REP_EATT
#define REP_EATT 1
#endif
#ifndef REP_POOL
#define REP_POOL 1
#endif
            for (int rq = 0; rq < REP_EATT; ++rq)
            for (int uid = gwv; uid < 4096; uid += NGW) attn_even_unit(uid, PROJ, KD, VT, MIX, p.sink + li * 8, lane_o, (LAS bf16x8*)(lds + wave * WAVE_LDS), lds + wave * WAVE_LDS + 2 * QST_SET);
            int lane_p; asm volatile("v_mbcnt_lo_u32_b32 %0, -1, 0\n\tv_mbcnt_hi_u32_b32 %0, -1, %0" : "=v"(lane_p));
            for (int rq = 0; rq < REP_POOL; ++rq)
            for (int r0 = gwv * 32; r0 < NTOK; r0 += NGW * 32) pool_rows32(r0, PROJ, MIX, lane_p);
        }
        }
        GRID_BAR();
        {
            const int K = odd ? 512 : 1024;
            const bf16_t* Wt = odd ? (const bf16_t*)(ws + WS_WOUT_O) + (size_t)li * 1024 * 512 : (const bf16_t*)(ws + WS_WOUT_E) + (size_t)li * 1024 * 1024;
            pg8::Gemm g{MIX, Wt, NTOK, 1024, K}; pg8::StaticOrder S; S.init(NTOK, 1024, G, bx);
#ifndef REP_OUT
#define REP_OUT 0
#endif
            for (int rq = 0; rq < REP_OUT; ++rq) {
                pg8::EpiRes E2{XB, PART, (bf16_t*)(ws + 800 * MiB), (float*)(ws + 930 * MiB)};
                pg8::gemm_phase<pg8::EpiRes, pg8::StaticOrder, true, true>(lds, g, S, E2, wave);
            }
            pg8::EpiRes E{XB, PART, XB, PART};
            pg8::gemm_phase<pg8::EpiRes, pg8::StaticOrder, true, true>(lds, g, S, E, wave);
        }
        GRID_BAR();
        {
            pg8::Gemm g{XB, (const bf16_t*)(ws + WS_WUP) + (size_t)layer * 4096 * 1024, NTOK, 4096, 1024}; pg8::StaticOrder S; S.init(NTOK, 4096, G, bx);
            pg8::EpiUp E{UB, PART};
#ifndef REP_UP
#define REP_UP 1
#endif
            for (int rep = 0; rep < REP_UP; ++rep)
            pg8::gemm_phase<pg8::EpiUp, pg8::StaticOrder, true, true>(lds, g, S, E, wave);
        }
        GRID_BAR();
        {
            pg8::Gemm g{UB, (const bf16_t*)(ws + WS_WDN) + (size_t)layer * 1024 * 4096, NTOK, 1024, 4096}; pg8::StaticOrder S; S.init(NTOK, 1024, G, bx);
#ifndef REP_DOWN
#define REP_DOWN 0
#endif
            for (int rq = 0; rq < REP_DOWN; ++rq) {
                pg8::EpiRes E2{XB, PART, (bf16_t*)(ws + 800 * MiB), (float*)(ws + 930 * MiB)};
                pg8::gemm_phase<pg8::EpiRes, pg8::StaticOrder, true, true>(lds, g, S, E2, wave);
            }
            pg8::EpiRes E{XB, PART, XB, PART};
            pg8::gemm_phase<pg8::EpiRes, pg8::StaticOrder, true, true>(lds, g, S, E, wave);
        }
        GRID_BAR();
    }
#ifndef REP_FINAL
#define REP_FINAL 1
#endif
    for (int rep_f = 0; rep_f < REP_FINAL; ++rep_f) {
    int lane_f; asm volatile("v_mbcnt_lo_u32_b32 %0, -1, 0\n\tv_mbcnt_hi_u32_b32 %0, -1, %0" : "=v"(lane_f)); const int gw_f = gw;
    for (int r0 = gw_f * 4; r0 < NTOK; r0 += NGW * 4) {
        unsigned long long xw[4][4];
        float ps = PART[(size_t)(lane_f & 15) * NTOK + r0 + (lane_f >> 4)];
#pragma unroll
        for (int q = 0; q < 4; ++q) { const unsigned long long* xr = (const unsigned long long*)(XB + (size_t)(r0 + q) * DM) + lane_f;
#pragma unroll
            for (int jj = 0; jj < 4; ++jj) xw[q][jj] = xr[64 * jj]; }
        ps += __builtin_bit_cast(float, __builtin_amdgcn_mov_dpp(__builtin_bit_cast(int, ps), 0xB1, 0xF, 0xF, true));
        ps += __builtin_bit_cast(float, __builtin_amdgcn_mov_dpp(__builtin_bit_cast(int, ps), 0x4E, 0xF, 0xF, true));
        ps += __builtin_bit_cast(float, __builtin_amdgcn_mov_dpp(__builtin_bit_cast(int, ps), 0x124, 0xF, 0xF, true));
        ps += __builtin_bit_cast(float, __builtin_amdgcn_mov_dpp(__builtin_bit_cast(int, ps), 0x128, 0xF, 0xF, true));
        const f32x4* gr = (const f32x4*)p.norm_final + lane_f;
#pragma unroll
        for (int q = 0; q < 4; ++q) {
            const float s = __builtin_bit_cast(float, __builtin_amdgcn_readlane(__builtin_bit_cast(int, ps), 16 * q));
            const float rs = __builtin_amdgcn_rsqf(s * (1.0f / 1024.0f) + 1e-6f);
            f32x4* orow = (f32x4*)(p.out + (size_t)(r0 + q) * DM) + lane_f;
#pragma unroll
            for (int jj = 0; jj < 4; ++jj) { const unsigned long long w = xw[q][jj]; const unsigned lo = (unsigned)w, hi = (unsigned)(w >> 32); const f32x4 gg = gr[64 * jj];
                f32x4 v; v[0] = __uint_as_float(lo << 16); v[1] = __uint_as_float(lo & 0xffff0000u); v[2] = __uint_as_float(hi << 16); v[3] = __uint_as_float(hi & 0xffff0000u);
                __builtin_nontemporal_store(v * rs * gg, &orow[64 * jj]); }
        }
    }
    }
}

extern "C" void kernel_launch(void* const* d_in, const int* in_sizes, int n_in, void* d_out, int out_size, void* d_ws, size_t ws_size, hipStream_t stream) {
    static int grid_blocks = 0;
    if (grid_blocks == 0) {
        if (n_in != 13 || out_size != NTOK * DM || ws_size < WS_END) { fprintf(stderr, "kernel_launch: unexpected shapes (n_in %d out %d ws %zu)\n", n_in, out_size, ws_size); grid_blocks = -1; return; }
        int dev = 0, cus = 0, per_cu = 0;
        hipGetDevice(&dev); hipDeviceGetAttribute(&cus, hipDeviceAttributeMultiprocessorCount, dev);
        hipFuncSetAttribute((const void*)fwd_megakernel, hipFuncAttributeMaxDynamicSharedMemorySize, LDS_ALLOC);
        hipOccupancyMaxActiveBlocksPerMultiprocessor(&per_cu, (const void*)fwd_megakernel, NTHREADS, LDS_ALLOC);
        if (per_cu < 1) per_cu = 1;
        (void)hipGetLastError();
        grid_blocks = cus * per_cu;
    }
    if (grid_blocks < 0) return;
    Params p{};
    p.x = (const float*)d_in[0]; p.norm_mix = (const float*)d_in[1]; p.norm_mlp = (const float*)d_in[2]; p.norm_final = (const float*)d_in[3];
    p.w_in_even = (const float*)d_in[4]; p.w_out_even = (const float*)d_in[5]; p.sink = (const float*)d_in[6]; p.w_pool = (const float*)d_in[7]; p.pool_scale = (const float*)d_in[8];
    p.w_in_odd = (const float*)d_in[9]; p.w_out_odd = (const float*)d_in[10]; p.w_up = (const float*)d_in[11]; p.w_down = (const float*)d_in[12];
    p.out = (float*)d_out; p.ws = (unsigned char*)d_ws;
    void* args[] = {&p};
    hipError_t e = hipLaunchCooperativeKernel((const void*)fwd_megakernel, dim3(grid_blocks), dim3(NTHREADS), args, LDS_ALLOC, stream);
    if (e != hipSuccess) fprintf(stderr, "cooperative launch failed: %s (grid %d)\n", hipGetErrorString(e), grid_blocks);
}
```

```cpp
#include <hip/hip_runtime.h>
#include <hip/hip_cooperative_groups.h>
#include <cstdio>
#include <cstdint>
namespace cg = cooperative_groups;
namespace pg8 {
#define PG8_LAS __attribute__((address_space(3)))
typedef unsigned short bf16_t;
typedef short bf16x8 __attribute__((ext_vector_type(8)));
typedef float f32x4 __attribute__((ext_vector_type(4)));
typedef unsigned u32x4 __attribute__((ext_vector_type(4)));
constexpr int BM = 256, BK = 64, HALF = 128, HTB = HALF * BK * 2  , STAGE_BYTES = 8 * HTB, NXCD = 8, WGM = 4;

__host__ __device__ __forceinline__ int lds_byte(int r, int c) { const int st = (r >> 4) * 2 + (c >> 5), rr = r & 15, cc = c & 31, ob = rr * 64 + cc * 2; return st * 1024 + (ob ^ (((ob >> 9) & 1) << 5)); }
__host__ __device__ __forceinline__ void stage_rc(int b, int& R, int& C) { const int st = b / 1024, sb = b % 1024, swz = sb ^ (((sb >> 9) & 1) << 5); R = (st >> 1) * 16 + swz / 64; C = (st & 1) * 32 + (swz % 64) / 2; }
__host__ __device__ __forceinline__ int perm32(int rho) { const int n = rho >> 4, i = rho & 15; return 8 * (i >> 2) + 4 * n + (i & 3); }

struct Unit { int pm, pn; };
struct Gemm { const bf16_t* A; const bf16_t* Bt; int M, N, K; };

struct StaticOrder {
    int nM, nN, nwg, G, c;
    __host__ __device__ void init(int M, int N, int G_, int c_) { nM = M / BM; nN = N / BM; nwg = nM * nN; G = G_; c = c_; }
    __host__ __device__ bool next(int i, Unit& u) const {
        const long L = (long)i * G + c; if (L >= nwg) return false;
        int wgid = (int)L; { const int q = nwg / NXCD, r = nwg % NXCD, xcd = wgid % NXCD, off = wgid / NXCD; wgid = (xcd < r ? xcd * (q + 1) : r * (q + 1) + (xcd - r) * q) + off; }
        const int nig = WGM * nN, gid = wgid / nig, fm = gid * WGM, gsz = (nM - fm) < WGM ? (nM - fm) : WGM;
        u.pm = fm + ((wgid % nig) % gsz); u.pn = (wgid % nig) / gsz; return true;
    }
    __device__ __forceinline__ void a_ready(const Unit&) const {}
    __device__ __forceinline__ void done(const Unit&) const {}
};

__device__ __forceinline__ unsigned cvt_pk_bf16(float lo, float hi) { unsigned r; asm volatile("v_cvt_pk_bf16_f32 %0, %1, %2" : "=v"(r) : "v"(lo), "v"(hi)); return r; }
__device__ __forceinline__ float sum_x16(float s) { auto r = __builtin_amdgcn_permlane16_swap(__float_as_uint(s), __float_as_uint(s), false, false); return __uint_as_float(r[0]) + __uint_as_float(r[1]); }
__device__ __forceinline__ float sum_x32(float s) { auto r = __builtin_amdgcn_permlane32_swap(__float_as_uint(s), __float_as_uint(s), false, false); return __uint_as_float(r[0]) + __uint_as_float(r[1]); }
__device__ __forceinline__ float peer_x16(float v, int fq) { auto r = __builtin_amdgcn_permlane16_swap(__float_as_uint(v), __float_as_uint(v), false, false); return __uint_as_float((fq & 1) ? r[0] : r[1]); }
constexpr float C2Q = 0.125f * 1.4426950408889634f;
__device__ __forceinline__ float row_rstd(const float* part, int row, int fq) {
    const float* pp = part + (size_t)(4 * fq) * 65536 + row; const f32x4 p = {pp[0], pp[65536], pp[2 * 65536], pp[3 * 65536]};
    float s = (p[0] + p[1]) + (p[2] + p[3]);
    s = sum_x16(s); s = sum_x32(s);
    return __builtin_amdgcn_rsqf(s * (1.0f / 1024.0f) + 1e-6f);
}
__device__ __forceinline__ void rows_part_load(const float* part, int row0  , int fq, f32x4 (&pl)[2][4]) {
#pragma unroll
    for (int ai = 0; ai < 2; ++ai)
#pragma unroll
        for (int m = 0; m < 4; ++m) { const float* pp = part + (size_t)(4 * fq) * 65536 + (row0 + ai * HALF + m * 16);
            pl[ai][m] = (f32x4){pp[0], pp[65536], pp[2 * 65536], pp[3 * 65536]}; }
}
__device__ __forceinline__ void rows_part_reduce(const f32x4 (&pl)[2][4], float (&rs)[2][4]) {
#pragma unroll
    for (int ai = 0; ai < 2; ++ai)
#pragma unroll
        for (int m = 0; m < 4; ++m) { float s = (pl[ai][m][0] + pl[ai][m][1]) + (pl[ai][m][2] + pl[ai][m][3]); s = sum_x16(s); s = sum_x32(s); rs[ai][m] = __builtin_amdgcn_rsqf(s * (1.0f / 1024.0f) + 1e-6f); }
}
__device__ __forceinline__ void rows_rstd(const float* part, int row0, int fq, float (&rs)[2][4]) { f32x4 pl[2][4]; rows_part_load(part, row0, fq, pl); rows_part_reduce(pl, rs); }
struct EpiProj {
    static constexpr bool PERM = true, AFTER_DRAIN = false, NEEDS_RSTD = true;
    bf16_t* proj; int ldp; const float* part; const float* cs; bf16_t* vt; bf16_t* kd; int odd;
    __device__ __forceinline__ void operator()(const f32x4 (&acc)[2][2][4][2], const Unit& u, int wr, int wc, int fr, int fq, PG8_LAS float* stash, int par, PG8_LAS unsigned char* stg, const Unit& un) const {
        const bool newpm = (un.pm != u.pm);
        f32x4 pln[2][4]; if (newpm) rows_part_load(part, un.pm * BM + wr * 64 + fr, fq, pln);
        float rsa[2][4];
#pragma unroll
        for (int ai = 0; ai < 2; ++ai)
#pragma unroll
            for (int m = 0; m < 4; ++m) rsa[ai][m] = stash[par * 256 + ai * HALF + wr * 64 + m * 16 + fr];
#pragma unroll
        for (int ai = 0; ai < 2; ++ai)
#pragma unroll
            for (int m = 0; m < 4; ++m) {
                if (m == 0) asm volatile("" ::: "memory");
                const int row = u.pm * BM + ai * HALF + wr * 64 + m * 16 + fr, pos = row & 4095, b = row >> 12;
                const float rs = rsa[ai][m];
#pragma unroll
                for (int bj = 0; bj < 2; ++bj) {
                    int kind;
                    if (odd) kind = (u.pn < 6) ? 0 : (u.pn == 6 ? 1 : 2);
                    else     kind = (u.pn < 2) ? 0 : (u.pn == 2 ? (wc < 2 ? 1 : 2) : 3);
                    float v[8];
#pragma unroll
                    for (int i = 0; i < 4; ++i) { v[i] = acc[ai][bj][m][0][i] * rs; v[4 + i] = acc[ai][bj][m][1][i] * rs; }
                    if (kind <= 1 && bj == 0) {
                        const f32x4 c0 = *(const f32x4*)(cs + pos * 16), c1 = *(const f32x4*)(cs + pos * 16 + 4), s0 = *(const f32x4*)(cs + pos * 16 + 8), s1 = *(const f32x4*)(cs + pos * 16 + 12);
#pragma unroll
                        for (int i = 0; i < 8; ++i) {
                            const float c = i < 4 ? c0[i & 3] : c1[i & 3], s = i < 4 ? s0[i & 3] : s1[i & 3];
                            const float pr = peer_x16(v[i], fq);
                            const float r = (fq == 0) ? (v[i] * c - pr * s) : (v[i] * c + pr * s);
                            v[i] = (fq < 2) ? r : v[i];
                        }
                    }
                    if (kind == 0) {
#pragma unroll
                        for (int i = 0; i < 8; ++i) v[i] *= C2Q;
                    }
                    { u32x4 w; w.x = cvt_pk_bf16(v[0], v[1]); w.y = cvt_pk_bf16(v[2], v[3]); w.z = cvt_pk_bf16(v[4], v[5]); w.w = cvt_pk_bf16(v[6], v[7]);
                      *(PG8_LAS u32x4*)(stg + fr * 144 + fq * 16 + bj * 64) = w; }
                }
                {
                    int kind;
                    if (odd) kind = (u.pn < 6) ? 0 : (u.pn == 6 ? 1 : 2);
                    else     kind = (u.pn < 2) ? 0 : (u.pn == 2 ? (wc < 2 ? 1 : 2) : 3);
#pragma unroll
                    for (int i = 0; i < 2; ++i) { const int c = fq * 16 + fr + 64 * i, rr = c >> 3, pc = c & 7;
                        const u32x4 w = *(const PG8_LAS u32x4*)(stg + rr * 144 + pc * 16);
                        const int rowc = row - fr + rr, posc = rowc & 4095;
                        if (kind == 1 || kind == 2) {
                            bf16_t* dst = (kind == 1) ? kd : vt;
                            if (odd) *(u32x4*)(dst + (size_t)(b * 4 + wc) * (4096 * 64) + (size_t)((posc & 15) * 256 + (posc >> 4)) * 64 + pc * 8) = w;
                            else     *(u32x4*)(dst + (size_t)(b * 2 + (wc & 1)) * (4096 * 64) + (size_t)posc * 64 + pc * 8) = w;
                        } else {
                            *(u32x4*)(proj + (size_t)rowc * ldp + u.pn * BM + wc * 64 + pc * 8) = w;
                        }
                    }
                }
            }
        if (newpm) { float rsn[2][4]; rows_part_reduce(pln, rsn);
          if (fq == 0) {
#pragma unroll
              for (int ai = 0; ai < 2; ++ai)
#pragma unroll
                  for (int m = 0; m < 4; ++m) stash[(par ^ 1) * 256 + ai * HALF + wr * 64 + m * 16 + fr] = rsn[ai][m]; } }
    }
};
struct EpiRes {
    static constexpr bool PERM = true, AFTER_DRAIN = false, NEEDS_RSTD = false;
    bf16_t* xb; float* part; bf16_t* xo_; float* po_;
    __device__ __forceinline__ void operator()(const f32x4 (&acc)[2][2][4][2], const Unit& u, int wr, int wc, int fr, int fq, PG8_LAS unsigned char* stg) const {
        const int lane = fq * 16 + fr;
        const size_t colw = (size_t)u.pn * BM + wc * 64;
        const int rowb = u.pm * BM + wr * 64;
        PG8_LAS unsigned char* st = stg + fr * 144 + fq * 16;
#pragma unroll
        for (int ai = 0; ai < 2; ++ai) {
        asm volatile("" ::: "memory");
        u32x4 xin[4][2];
#pragma unroll
        for (int m = 0; m < 4; ++m)
#pragma unroll
            for (int i = 0; i < 2; ++i) { const int c = lane + 64 * i; xin[m][i] = *(const u32x4*)(xb + (size_t)(rowb + ai * HALF + m * 16 + (c >> 3)) * 1024 + colw + (c & 7) * 8); }
#pragma unroll
        for (int m = 0; m < 4; ++m) {
            const int row = rowb + ai * HALF + m * 16 + fr;
#pragma unroll
            for (int i = 0; i < 2; ++i) { const int c = lane + 64 * i; *(PG8_LAS u32x4*)(stg + (c >> 3) * 144 + (c & 7) * 16) = xin[m][i]; }
            float ss = 0.f;
#pragma unroll
            for (int bj = 0; bj < 2; ++bj) {
                const u32x4 xo = *(const PG8_LAS u32x4*)(st + bj * 64);
                float v[8];
#pragma unroll
                for (int i = 0; i < 4; ++i) { v[2 * i] = __uint_as_float(xo[i] << 16) + acc[ai][bj][m][i >> 1][(2 * i) & 3]; v[2 * i + 1] = __uint_as_float(xo[i] & 0xffff0000u) + acc[ai][bj][m][i >> 1][(2 * i + 1) & 3]; }
                u32x4 w; w.x = cvt_pk_bf16(v[0], v[1]); w.y = cvt_pk_bf16(v[2], v[3]); w.z = cvt_pk_bf16(v[4], v[5]); w.w = cvt_pk_bf16(v[6], v[7]);
                *(PG8_LAS u32x4*)(st + bj * 64) = w;
                ss += ((v[0] * v[0] + v[1] * v[1]) + (v[2] * v[2] + v[3] * v[3])) + ((v[4] * v[4] + v[5] * v[5]) + (v[6] * v[6] + v[7] * v[7]));
            }
#pragma unroll
            for (int i = 0; i < 2; ++i) { const int c = lane + 64 * i; const u32x4 w = *(const PG8_LAS u32x4*)(stg + (c >> 3) * 144 + (c & 7) * 16);
                *(u32x4*)(xo_ + (size_t)(row - fr + (c >> 3)) * 1024 + colw + (c & 7) * 8) = w; }
            ss = sum_x16(ss); ss = sum_x32(ss);
            if (fq == 0) po_[(size_t)(u.pn * 4 + wc) * 65536 + row] = ss;
        }
        }
    }
};
struct EpiUp {
    static constexpr bool PERM = true, AFTER_DRAIN = false, NEEDS_RSTD = true;
    bf16_t* uo; const float* part;
    __device__ __forceinline__ void operator()(const f32x4 (&acc)[2][2][4][2], const Unit& u, int wr, int wc, int fr, int fq, PG8_LAS float* stash, int par, PG8_LAS unsigned char* stg, const Unit& un) const {
        const bool newpm = (un.pm != u.pm);
        f32x4 pln[2][4]; if (newpm) rows_part_load(part, un.pm * BM + wr * 64 + fr, fq, pln);
        float rsa[2][4];
#pragma unroll
        for (int ai = 0; ai < 2; ++ai)
#pragma unroll
            for (int m = 0; m < 4; ++m) rsa[ai][m] = stash[par * 256 + ai * HALF + wr * 64 + m * 16 + fr];
#pragma unroll
        for (int ai = 0; ai < 2; ++ai)
#pragma unroll
            for (int m = 0; m < 4; ++m) {
                const int row = u.pm * BM + ai * HALF + wr * 64 + m * 16 + fr;
                const float rs = rsa[ai][m];
                PG8_LAS unsigned char* st = stg + fr * 144 + fq * 16;
#pragma unroll
                for (int bj = 0; bj < 2; ++bj) {
                    float v[8];
#pragma unroll
                    for (int i = 0; i < 4; ++i) { v[i] = acc[ai][bj][m][0][i] * rs; v[4 + i] = acc[ai][bj][m][1][i] * rs; }
#pragma unroll
                    for (int i = 0; i < 8; ++i) { const float r = fmaxf(v[i], 0.f); v[i] = r * r; }
                    u32x4 w; w.x = cvt_pk_bf16(v[0], v[1]); w.y = cvt_pk_bf16(v[2], v[3]); w.z = cvt_pk_bf16(v[4], v[5]); w.w = cvt_pk_bf16(v[6], v[7]);
                    *(PG8_LAS u32x4*)(st + bj * 64) = w;
                }
#pragma unroll
                for (int i = 0; i < 2; ++i) { const int c = fq * 16 + fr + 64 * i, rr = c >> 3, pc = c & 7;
                    const u32x4 w = *(const PG8_LAS u32x4*)(stg + rr * 144 + pc * 16);
                    __builtin_nontemporal_store(w, (u32x4*)(uo + (size_t)(row - fr + rr) * 4096 + u.pn * BM + wc * 64 + pc * 8)); }
            }
        if (newpm) { float rsn[2][4]; rows_part_reduce(pln, rsn);
          if (fq == 0) {
#pragma unroll
              for (int ai = 0; ai < 2; ++ai)
#pragma unroll
                  for (int m = 0; m < 4; ++m) stash[(par ^ 1) * 256 + ai * HALF + wr * 64 + m * 16 + fr] = rsn[ai][m]; } }
    }
};
template <class Epi, class Sched, bool ALIGN_EPI = false, bool SP2 = false>
__device__ __forceinline__ void gemm_phase(PG8_LAS unsigned char* lds, const Gemm g, const Sched& S, const Epi& E, const int wave_s) {
    int tid_o; asm volatile("v_mbcnt_lo_u32_b32 %0, -1, 0\n\tv_mbcnt_hi_u32_b32 %0, -1, %0" : "=v"(tid_o)); tid_o += wave_s * 64;
    const int tid = tid_o, wid = __builtin_amdgcn_readfirstlane(tid >> 6), lane = tid & 63, wr = wid >> 2, wc = wid & 3, fr = lane & 15, fq = lane >> 4;
    const int K = g.K, nt = K / BK;
    unsigned voffA[2], voffB[2];
#pragma unroll
    for (int i = 0; i < 2; ++i) { int R, C; stage_rc(tid * 16 + i * 8192, R, C); const int Rb = Epi::PERM ? ((R >> 5) * 64 + perm32(R & 31)) : R;
        voffA[i] = (unsigned)(R * K + C) * 2u; voffB[i] = (unsigned)(Rb * K + C) * 2u; }
    const size_t kstep = (size_t)(BK * 2);
    const size_t hstep = (size_t)HALF * K * 2;
    const size_t bhstep = Epi::PERM ? (size_t)32 * K * 2 : hstep;
    const size_t tstep = 2 * hstep;
    const unsigned ldsw = (unsigned)wid * 1024u;
    const int aoff = lds_byte(wr * 64 + fr, fq * 8), boff = lds_byte(wc * 32 + fr, fq * 8);
#define PG8_SA(b, h) (((b) * 2 + (h)) * HTB)
#define PG8_SB(b, h) ((4 + (b) * 2 + (h)) * HTB)
#define PG8_STAGE(bufoff, gbase, voff) do { _Pragma("unroll") for (int _i = 0; _i < 2; ++_i) \
        __builtin_amdgcn_global_load_lds((const unsigned*)((const char*)(gbase) + (voff)[_i]), (PG8_LAS unsigned*)(lds + (bufoff) + ldsw + _i * 8192), 16, 0, 0); } while (0)
#define PG8_LDA(dst, b, h) do { _Pragma("unroll") for (int m = 0; m < 4; ++m) _Pragma("unroll") for (int k = 0; k < 2; ++k) dst[m][k] = *(const PG8_LAS bf16x8*)(lds + PG8_SA(b, h) + aoff + m * 2048 + k * 1024); } while (0)
#define PG8_LDB(dst, b, h) do { _Pragma("unroll") for (int n = 0; n < 2; ++n) _Pragma("unroll") for (int k = 0; k < 2; ++k) dst[n][k] = *(const PG8_LAS bf16x8*)(lds + PG8_SB(b, h) + boff + n * 2048 + k * 1024); } while (0)
#define PG8_MMA(ai, bj, At, Bt) do { __builtin_amdgcn_s_setprio(1); _Pragma("unroll") for (int m = 0; m < 4; ++m) _Pragma("unroll") for (int n = 0; n < 2; ++n) _Pragma("unroll") for (int k = 0; k < 2; ++k) \
        acc[ai][bj][m][n] = __builtin_amdgcn_mfma_f32_16x16x32_bf16(Bt[n][k], At[m][k], acc[ai][bj][m][n], 0, 0, 0); __builtin_amdgcn_s_setprio(0); } while (0)
#define PG8_WAIT_V(n) asm volatile("s_waitcnt vmcnt(" #n ")" ::: "memory")
#define PG8_WAIT_L(n) asm volatile("s_waitcnt lgkmcnt(" #n ")" ::: "memory")
#define PG8_BAR __builtin_amdgcn_s_barrier()
#define PG8_SCHED __builtin_amdgcn_sched_barrier(0)
    Unit cur, nxt; int ui = 0;
    if (!S.next(0, cur)) return;
    PG8_LAS float* rs_stash = (PG8_LAS float*)(lds + STAGE_BYTES); int rs_par = 0;
    if constexpr (Epi::NEEDS_RSTD) { float rs0[2][4]; rows_rstd(E.part, cur.pm * BM + wr * 64 + fr, fq, rs0);
        if (fq == 0) {
#pragma unroll
            for (int ai = 0; ai < 2; ++ai)
#pragma unroll
                for (int m = 0; m < 4; ++m) rs_stash[ai * HALF + wr * 64 + m * 16 + fr] = rs0[ai][m]; } }
    f32x4 acc[2][2][4][2];
#pragma unroll
    for (int a = 0; a < 2; ++a)
#pragma unroll
        for (int b = 0; b < 2; ++b)
#pragma unroll
            for (int m = 0; m < 4; ++m)
#pragma unroll
                for (int n = 0; n < 2; ++n) acc[a][b][m][n] = (f32x4){0.f, 0.f, 0.f, 0.f};
    bf16x8 At[4][2], B0[2][2], B1[2][2];
    const char* cA = (const char*)g.A + (size_t)cur.pm * tstep; const char* cB = (const char*)g.Bt + (size_t)cur.pn * tstep;
    S.a_ready(cur);
    if constexpr (SP2) {
        PG8_STAGE(PG8_SB(0, 0), cB, voffB); PG8_STAGE(PG8_SB(0, 1), cB + bhstep, voffB); PG8_STAGE(PG8_SA(0, 0), cA, voffA); PG8_STAGE(PG8_SA(0, 1), cA + hstep, voffA);
        if (wr == 1) PG8_BAR;
        PG8_WAIT_V(2); PG8_BAR;
        PG8_STAGE(PG8_SB(1, 0), cB + kstep, voffB); PG8_STAGE(PG8_SA(1, 0), cA + kstep, voffA); PG8_STAGE(PG8_SB(1, 1), cB + bhstep + kstep, voffB);
        PG8_WAIT_V(6); PG8_BAR;
    } else {
        PG8_STAGE(PG8_SB(0, 0), cB, voffB); PG8_STAGE(PG8_SA(0, 0), cA, voffA); PG8_STAGE(PG8_SB(0, 1), cB + bhstep, voffB); PG8_STAGE(PG8_SA(0, 1), cA + hstep, voffA);
        if (wr == 1) PG8_BAR;
        PG8_WAIT_V(4); PG8_BAR;
        PG8_STAGE(PG8_SB(1, 0), cB + kstep, voffB); PG8_STAGE(PG8_SA(1, 0), cA + kstep, voffA); PG8_STAGE(PG8_SB(1, 1), cB + bhstep + kstep, voffB);
        PG8_WAIT_V(6); PG8_BAR;
    }
    for (;;) {
        const bool has_next = S.next(ui + 1, nxt);
        const char* nA = has_next ? (const char*)g.A + (size_t)nxt.pm * tstep : cA; const char* nB = has_next ? (const char*)g.Bt + (size_t)nxt.pn * tstep : cB;
        for (int t = 0; t < nt; t += 2) {
            const bool last = (t == nt - 2);
            const char* a1 = cA + (size_t)(t + 1) * kstep;
            const char* a2 = last ? nA : cA + (size_t)(t + 2) * kstep; const char* b2 = last ? nB : cB + (size_t)(t + 2) * kstep;
            const char* a3 = a2 + kstep; const char* b3 = b2 + kstep;
            if (last && has_next) S.a_ready(nxt);
            if constexpr (SP2) {
            PG8_LDB(B0, 0, 0); PG8_LDB(B1, 0, 1); PG8_SCHED; PG8_LDA(At, 0, 0); PG8_STAGE(PG8_SA(1, 1), a1 + hstep, voffA);
            PG8_WAIT_V(8); PG8_WAIT_L(0); PG8_BAR; PG8_MMA(0, 0, At, B0); PG8_MMA(0, 1, At, B1); PG8_BAR; PG8_SCHED;
            PG8_LDA(At, 0, 1); PG8_STAGE(PG8_SB(0, 0), b2, voffB); PG8_STAGE(PG8_SB(0, 1), b2 + bhstep, voffB); PG8_STAGE(PG8_SA(0, 0), a2, voffA);
            PG8_WAIT_V(8); PG8_WAIT_L(0); PG8_BAR; PG8_MMA(1, 0, At, B0); PG8_MMA(1, 1, At, B1); PG8_BAR; PG8_SCHED;
            PG8_LDB(B0, 1, 0); PG8_LDB(B1, 1, 1); PG8_SCHED; PG8_LDA(At, 1, 0); PG8_STAGE(PG8_SA(0, 1), a2 + hstep, voffA);
            PG8_WAIT_V(8); PG8_WAIT_L(0); PG8_BAR; PG8_MMA(0, 0, At, B0); PG8_MMA(0, 1, At, B1); PG8_BAR; PG8_SCHED;
            PG8_LDA(At, 1, 1); PG8_STAGE(PG8_SB(1, 0), b3, voffB); PG8_STAGE(PG8_SB(1, 1), b3 + bhstep, voffB); PG8_STAGE(PG8_SA(1, 0), a3, voffA);
            PG8_WAIT_V(8); PG8_WAIT_L(0); PG8_BAR; PG8_MMA(1, 0, At, B0); PG8_MMA(1, 1, At, B1); PG8_BAR; PG8_SCHED;
            } else {
            PG8_LDB(B0, 0, 0); PG8_SCHED; PG8_LDA(At, 0, 0); PG8_STAGE(PG8_SA(1, 1), a1 + hstep, voffA);
            PG8_WAIT_L(8); PG8_BAR; PG8_WAIT_L(0); PG8_MMA(0, 0, At, B0); PG8_BAR; PG8_SCHED;
            PG8_LDB(B1, 0, 1); PG8_STAGE(PG8_SB(0, 0), b2, voffB);
            PG8_BAR; PG8_WAIT_L(0); PG8_MMA(0, 1, At, B1); PG8_BAR;
            PG8_LDA(At, 0, 1); PG8_STAGE(PG8_SA(0, 0), a2, voffA);
            PG8_BAR; PG8_WAIT_L(0); PG8_MMA(1, 0, At, B0); PG8_BAR; PG8_SCHED;
            PG8_STAGE(PG8_SB(0, 1), b2 + bhstep, voffB);
            PG8_WAIT_V(6); PG8_BAR; PG8_MMA(1, 1, At, B1); PG8_BAR;
            PG8_LDB(B0, 1, 0); PG8_SCHED; PG8_LDA(At, 1, 0); PG8_STAGE(PG8_SA(0, 1), a2 + hstep, voffA);
            PG8_WAIT_L(8); PG8_BAR; PG8_WAIT_L(0); PG8_MMA(0, 0, At, B0); PG8_BAR; PG8_SCHED;
            PG8_LDB(B1, 1, 1); PG8_STAGE(PG8_SB(1, 0), b3, voffB);
            PG8_BAR; PG8_WAIT_L(0); PG8_MMA(0, 1, At, B1); PG8_BAR;
            PG8_LDA(At, 1, 1); PG8_STAGE(PG8_SA(1, 0), a3, voffA);
            PG8_BAR; PG8_WAIT_L(0); PG8_MMA(1, 0, At, B0); PG8_BAR; PG8_SCHED;
            PG8_STAGE(PG8_SB(1, 1), b3 + bhstep, voffB);
            PG8_WAIT_V(6); PG8_BAR; PG8_MMA(1, 1, At, B1); PG8_BAR;
            }
        }
        if constexpr (ALIGN_EPI) { if (wr == 0) PG8_BAR; }
        if constexpr (!Epi::AFTER_DRAIN) { if constexpr (Epi::NEEDS_RSTD) E(acc, cur, wr, wc, fr, fq, rs_stash, rs_par, (PG8_LAS unsigned char*)(lds + STAGE_BYTES + 2048 + wid * 2304), has_next ? nxt : cur); else E(acc, cur, wr, wc, fr, fq, (PG8_LAS unsigned char*)(lds + STAGE_BYTES + 2048 + wid * 2304)); S.done(cur); }
        if (!has_next) break;
#pragma unroll
        for (int a = 0; a < 2; ++a)
#pragma unroll
            for (int b = 0; b < 2; ++b)
#pragma unroll
                for (int m = 0; m < 4; ++m)
#pragma unroll
                    for (int n = 0; n < 2; ++n) acc[a][b][m][n] = (f32x4){0.f, 0.f, 0.f, 0.f};
        if (nxt.pm != cur.pm) rs_par ^= 1;
        cur = nxt; cA = nA; cB = nB; ++ui;
        if constexpr (ALIGN_EPI) { if (wr == 1) PG8_BAR; }
    }
    PG8_WAIT_V(0);
    if constexpr (!ALIGN_EPI) { if (wr == 0) PG8_BAR; }
    PG8_BAR;
    if constexpr (Epi::AFTER_DRAIN) { E.fused(acc, cur, wr, wc, fr, fq, lds, wid, lane); S.done(cur); }
#undef PG8_SA
#undef PG8_SB
#undef PG8_STAGE
#undef PG8_LDA
#undef PG8_LDB
#undef PG8_MMA
#undef PG8_WAIT_V
#undef PG8_WAIT_L
#undef PG8_BAR
#undef PG8_SCHED
}
}
#define LAS __attribute__((address_space(3)))
typedef pg8::bf16_t bf16_t;
typedef short bf16x8 __attribute__((ext_vector_type(8)));
typedef float f32x4 __attribute__((ext_vector_type(4)));
typedef float f32x16 __attribute__((ext_vector_type(16)));
typedef unsigned u32x4 __attribute__((ext_vector_type(4)));
typedef unsigned u32x2 __attribute__((ext_vector_type(2)));

constexpr int NTOK = 65536, DM = 1024, SEQ = 4096, NB = 16, DFF = 4096;
constexpr int NWAVES = 8, NTHREADS = 512;
constexpr int LDS_BYTES = 131072, LDS_ALLOC = 163840, WAVE_LDS = 20480, MISC_OFF = LDS_ALLOC - 256;
constexpr size_t MiB = (size_t)1 << 20;
constexpr size_t WS_WIN_E = 0, WS_WOUT_E = 5 * MiB, WS_WIN_O = 9 * MiB, WS_WOUT_O = 17 * MiB, WS_WUP = 19 * MiB, WS_WDN = 51 * MiB;
constexpr size_t WS_WF = 83 * MiB, WS_CS = 87 * MiB, WS_PART = 88 * MiB, WS_BAR = 92 * MiB, WS_LSE = 93 * MiB, WS_XB = 96 * MiB, WS_BIG = 224 * MiB;
constexpr size_t WS_PROJ = WS_BIG, WS_VT = WS_BIG + 256 * MiB, WS_MIX = WS_BIG + 352 * MiB, WS_KD = WS_BIG + 480 * MiB, WS_U = WS_BIG, WS_END = WS_BIG + 576 * MiB;

struct Params {
    const float *x, *norm_mix, *norm_mlp, *norm_final, *w_in_even, *w_out_even, *sink, *w_pool, *pool_scale, *w_in_odd, *w_out_odd, *w_up, *w_down;
    float* out; unsigned char* ws;
};

__device__ __forceinline__ unsigned pk2(float lo, float hi) { return pg8::cvt_pk_bf16(lo, hi); }
__device__ __forceinline__ float wave_sum(float v) {
#pragma unroll
    for (int o = 1; o < 64; o <<= 1) v += __shfl_xor(v, o);
    return v;
}

#define XB_TMO      128
#define XB_XCNT(j)  (256  + 64 * (j))
#define XB_XSUB(j)  (1280 + 64 * (j))
#define XB_XGEN(j)  (2304 + 64 * (j))
#define XB_TOP      3328
#define XB_TOPGEN   3392
#define XCD_BAR_WORDS 3456
#define XB_SPIN_CAP (1u << 22)
__device__ __forceinline__ unsigned xb_ld(unsigned* p)              { return __hip_atomic_load(p, __ATOMIC_RELAXED, __HIP_MEMORY_SCOPE_AGENT); }
__device__ __forceinline__ unsigned xb_add(unsigned* p, unsigned v) { return __hip_atomic_fetch_add(p, v, __ATOMIC_RELAXED, __HIP_MEMORY_SCOPE_AGENT); }
__device__ __forceinline__ unsigned xb_xcc_id() { return (unsigned)__builtin_amdgcn_s_getreg((3 << 11) | 20) & 0xFu; }
#define XB_SPIN(cond, bar) do { unsigned _sp = 0; while (cond) { __builtin_amdgcn_s_sleep(1); \
    if ((++_sp & 255u) == 0u) { if (xb_ld(&(bar)[XB_TMO])) break; if (_sp > XB_SPIN_CAP) { atomicAdd(&(bar)[XB_TMO], 1u); break; } } } } while (0)
struct XcdBarrier { unsigned* bar; unsigned x; volatile LAS unsigned* st; };
__device__ __forceinline__ bool wg_leader(int wave) { int ln; asm volatile("v_mbcnt_lo_u32_b32 %0, -1, 0\n\tv_mbcnt_hi_u32_b32 %0, -1, %0" : "=v"(ln)); return wave == 0 && ln == 0; }
__device__ __forceinline__ XcdBarrier xcd_barrier_post(unsigned* bar, volatile LAS unsigned* st, int wave) {
    XcdBarrier b; b.bar = bar; b.x = xb_xcc_id(); b.st = st;
    if (wg_leader(wave)) (void)xb_add(&bar[XB_XCNT(b.x)], 1u);
    return b;
}
__device__ __forceinline__ void xcd_barrier_complete(unsigned* bar, unsigned x, unsigned& nloc, unsigned& nx) {
    const unsigned G = gridDim.x * gridDim.y * gridDim.z;
    unsigned sum, cnt, mine, sp = 0u;
    for (;;) {
        sum = 0u; cnt = 0u; mine = 0u;
#pragma unroll
        for (unsigned j = 0; j < 16; ++j) { const unsigned c = xb_ld(&bar[XB_XCNT(j)]); sum += c; cnt += (c > 0u) ? 1u : 0u; mine = (j == x) ? c : mine; }
        if (sum == G) break;
        __builtin_amdgcn_s_sleep(1);
        if ((++sp & 255u) == 0u) { if (xb_ld(&bar[XB_TMO])) break; if (sp > XB_SPIN_CAP) { atomicAdd(&bar[XB_TMO], 1u); break; } }
    }
    nloc = mine > 0u ? mine : 1u; nx = cnt > 0u ? cnt : 1u;
}
__device__ __forceinline__ void xcd_barrier(const XcdBarrier& b, int wave) {
    asm volatile("s_waitcnt vmcnt(0)" ::: "memory");
    __syncthreads();
    if (wg_leader(wave)) {
        unsigned* bar = b.bar;
        __builtin_amdgcn_s_waitcnt(0);
        unsigned nloc = b.st[0], nx = b.st[1];
        if (nloc == 0u) { xcd_barrier_complete(bar, b.x, nloc, nx); b.st[0] = nloc; b.st[1] = nx; }
        const unsigned old = xb_add(&bar[XB_XSUB(b.x)], 1u);
        const unsigned gen = old / nloc;
        if (old + 1u == (gen + 1u) * nloc) {
            __builtin_amdgcn_fence(__ATOMIC_RELEASE, "agent");
            asm volatile("s_waitcnt vmcnt(0)" ::: "memory");
            const unsigned og = xb_add(&bar[XB_TOP], 1u);
            const unsigned tg = og / nx;
            if (og + 1u == (tg + 1u) * nx) xb_add(&bar[XB_TOPGEN], 1u);
            else XB_SPIN(xb_ld(&bar[XB_TOPGEN]) == tg, bar);
            __builtin_amdgcn_fence(__ATOMIC_ACQUIRE, "agent");
            xb_add(&bar[XB_XGEN(b.x)], 1u);
            asm volatile("s_waitcnt vmcnt(0)" ::: "memory");
        } else {
            XB_SPIN(xb_ld(&bar[XB_XGEN(b.x)]) == gen, bar);
            __builtin_amdgcn_fence(__ATOMIC_ACQUIRE, "agent");
            asm volatile("s_waitcnt vmcnt(0)" ::: "memory");
        }
    }
    __syncthreads();
}

__device__ __forceinline__ void transpose_item(const float* W, const float* gain, int N, bf16_t* WT, int ldk, int koff, LAS float* scr, int item, int lane) {
    const int nblk = N / 32, kb = item / nblk, nb = item % nblk, k0 = 64 * kb, n0 = 32 * nb;
    const int c4 = lane & 7, kr = lane >> 3;
#pragma unroll
    for (int i = 0; i < 8; ++i) { const int kk = 8 * i + kr; const float g = gain ? gain[k0 + kk] : 1.f; const f32x4 v = *(const f32x4*)(W + (size_t)(k0 + kk) * N + n0 + 4 * c4);
        LAS float* d = scr + kk * 33 + 4 * c4; d[0] = v[0] * g; d[1] = v[1] * g; d[2] = v[2] * g; d[3] = v[3] * g; }
    asm volatile("s_waitcnt lgkmcnt(0)" ::: "memory");
    const int c = lane & 7;
#pragma unroll
    for (int j = 0; j < 4; ++j) { const int n = (lane >> 3) + 8 * j; const LAS float* s = scr + (8 * c) * 33 + n;
        u32x4 o; o.x = pk2(s[0 * 33], s[1 * 33]); o.y = pk2(s[2 * 33], s[3 * 33]); o.z = pk2(s[4 * 33], s[5 * 33]); o.w = pk2(s[6 * 33], s[7 * 33]);
        *(u32x4*)(WT + (size_t)(n0 + n) * ldk + koff + k0 + 8 * c) = o; }
    asm volatile("s_waitcnt lgkmcnt(0)" ::: "memory");
}
struct Job { const float* W; const float* g; int Kr, N; bf16_t* WT; int ldk, koff; };
__device__ __forceinline__ Job get_job(const Params& p, int j) {
    Job J; unsigned char* ws = p.ws;
    if (j < 6) { const int e = j / 3, t = j % 3;
        if (t == 0) { J.W = p.w_in_even + (size_t)e * 1024 * 1280; J.g = p.norm_mix + (2 * e) * 1024; J.Kr = 1024; J.N = 1280; J.WT = (bf16_t*)(ws + WS_WIN_E) + (size_t)e * 1280 * 1024; J.ldk = 1024; J.koff = 0; }
        else if (t == 1) { J.W = p.w_out_even + (size_t)e * 1024 * 1024; J.g = nullptr; J.Kr = 512; J.N = 1024; J.WT = (bf16_t*)(ws + WS_WOUT_E) + (size_t)e * 1024 * 1024; J.ldk = 1024; J.koff = 0; }
        else { J.W = p.w_out_even; J.g = nullptr; J.Kr = 0; J.N = 1024; J.WT = (bf16_t*)(ws + WS_WOUT_E) + (size_t)e * 1024 * 1024; J.ldk = 1024; J.koff = 512; }
    } else if (j < 10) { const int o = (j - 6) / 2, t = (j - 6) % 2;
        if (t == 0) { J.W = p.w_in_odd + (size_t)o * 1024 * 2048; J.g = p.norm_mix + (2 * o + 1) * 1024; J.Kr = 1024; J.N = 2048; J.WT = (bf16_t*)(ws + WS_WIN_O) + (size_t)o * 2048 * 1024; J.ldk = 1024; J.koff = 0; }
        else { J.W = p.w_out_odd + (size_t)o * 512 * 1024; J.g = nullptr; J.Kr = 512; J.N = 1024; J.WT = (bf16_t*)(ws + WS_WOUT_O) + (size_t)o * 1024 * 512; J.ldk = 512; J.koff = 0; }
    } else { const int l = (j - 10) / 2, t = (j - 10) % 2;
        if (t == 0) { J.W = p.w_up + (size_t)l * 1024 * 4096; J.g = p.norm_mlp + l * 1024; J.Kr = 1024; J.N = 4096; J.WT = (bf16_t*)(ws + WS_WUP) + (size_t)l * 4096 * 1024; J.ldk = 1024; J.koff = 0; }
        else { J.W = p.w_down + (size_t)l * 4096 * 1024; J.g = nullptr; J.Kr = 4096; J.N = 1024; J.WT = (bf16_t*)(ws + WS_WDN) + (size_t)l * 1024 * 4096; J.ldk = 4096; J.koff = 0; }
    }
    return J;
}
constexpr int NJOBS = 18;

__device__ __forceinline__ void sincos_d(float a, float& c, float& s) {
    const double x = (double)a; const double k = __builtin_rint(x * 0.63661977236758134308);
    const double r = x - k * 1.57079632679489661923; const double r2 = r * r;
    double sp = -1.0 / 1307674368000.0; sp = sp * r2 + 1.0 / 6227020800.0; sp = sp * r2 - 1.0 / 39916800.0; sp = sp * r2 + 1.0 / 362880.0; sp = sp * r2 - 1.0 / 5040.0; sp = sp * r2 + 1.0 / 120.0; sp = sp * r2 - 1.0 / 6.0; sp = sp * r2 + 1.0;
    const double sn = sp * r;
    double cp = 1.0 / 20922789888000.0; cp = cp * r2 - 1.0 / 87178291200.0; cp = cp * r2 + 1.0 / 479001600.0; cp = cp * r2 - 1.0 / 3628800.0; cp = cp * r2 + 1.0 / 40320.0; cp = cp * r2 - 1.0 / 720.0; cp = cp * r2 + 1.0 / 24.0; cp = cp * r2 - 0.5; cp = cp * r2 + 1.0;
    const int q = ((int)k) & 3;
    const double cc = (q == 0) ? cp : (q == 1) ? -sn : (q == 2) ? -cp : sn;
    const double ss = (q == 0) ? sn : (q == 1) ? cp : (q == 2) ? -sn : -cp;
    c = (float)cc; s = (float)ss;
}

struct KVFrag { bf16x8 kr[4]; bf16x8 vr[4]; };
__device__ __forceinline__ void load_frags(KVFrag& f, const bf16_t* K0, const bf16_t* V0, int kb, int mode, int rsel, int lane) {
    if (mode == 0) {
        const int eo = kb * 64 + lane * 8;
        const bf16_t* kp = K0 + eo; const bf16_t* vp = V0 + eo;
#pragma unroll
        for (int i = 0; i < 4; ++i) { f.kr[i] = *(const bf16x8*)(kp + 512 * i); f.vr[i] = *(const bf16x8*)(vp + 512 * i); }
    } else if (mode == 1) {
        const int k0 = lane >> 3;
        const int eo = ((((k0 & 3) * 4 + rsel) * 256) + (kb >> 2) + (k0 >> 2)) * 64 + (lane & 7) * 8;
        const bf16_t* kp = K0 + eo; const bf16_t* vp = V0 + eo;
#pragma unroll
        for (int i = 0; i < 4; ++i) { f.kr[i] = *(const bf16x8*)(kp + 128 * i); f.vr[i] = *(const bf16x8*)(vp + 128 * i); }
    } else {
        const int k0 = lane >> 3;
        const int eo = (k0 * 256 + (kb >> 4)) * 64 + (lane & 7) * 8;
        const bf16_t* kp = K0 + eo; const bf16_t* vp = V0 + eo;
#pragma unroll
        for (int i = 0; i < 4; ++i) { const int o = (i & 1) * (8 * 256 * 64) + (i >> 1) * 64; f.kr[i] = *(const bf16x8*)(kp + o); f.vr[i] = *(const bf16x8*)(vp + o); }
    }
}
typedef short s16x4 __attribute__((ext_vector_type(4)));
constexpr int KST_OFF = 6144, KST_RS = 144;
constexpr int VST_RS = 192;
struct HState { f32x16 o[2]; float m, l; };
__device__ __forceinline__ void stage_v(const KVFrag& f, LAS unsigned char* vst, int lane, int hi, bf16x8 (&vf)[2][2], bf16x8 (&kf)[4]) {
#pragma unroll
    for (int i = 0; i < 4; ++i) { const int c = lane + 64 * i; *(LAS bf16x8*)(vst + (c >> 3) * VST_RS + (c & 7) * 16) = f.vr[i]; *(LAS bf16x8*)(vst + KST_OFF + (c >> 3) * KST_RS + (c & 7) * 16) = f.kr[i]; }
    const LAS unsigned char* tb = vst + (8 * hi + ((lane & 15) >> 2)) * VST_RS + (16 * ((lane >> 4) & 1) + 4 * (lane & 3)) * 2;
#pragma unroll
    for (int ks = 0; ks < 2; ++ks)
#pragma unroll
        for (int dh = 0; dh < 2; ++dh) {
            const s16x4 lo = __builtin_bit_cast(s16x4, __builtin_amdgcn_ds_read_tr16_b64_v4i16((LAS s16x4*)(tb + (16 * ks) * VST_RS + dh * 64)));
            const s16x4 hi4 = __builtin_bit_cast(s16x4, __builtin_amdgcn_ds_read_tr16_b64_v4i16((LAS s16x4*)(tb + (16 * ks + 4) * VST_RS + dh * 64)));
            vf[ks][dh] = (bf16x8){lo[0], lo[1], lo[2], lo[3], hi4[0], hi4[1], hi4[2], hi4[3]};
        }
    const int l31 = lane & 31, jsw = (l31 & 0x13) | ((l31 & 4) << 1) | ((l31 & 8) >> 1);
    const LAS unsigned char* kb_ = vst + KST_OFF + jsw * KST_RS + 16 * hi;
#pragma unroll
    for (int d0 = 0; d0 < 4; ++d0) kf[d0] = *(const LAS bf16x8*)(kb_ + 32 * d0);
}
struct ORows { unsigned base_row, pstride, amask, ashift, ld, hcol; };
__device__ __forceinline__ unsigned orow_off(const ORows& R, int rr) { return (R.base_row + R.pstride * ((unsigned)rr & R.amask)) * R.ld + R.hcol + 64u * ((unsigned)rr >> R.ashift); }
constexpr int QST_RS = 144, QST_SET = 32 * QST_RS;
__device__ __forceinline__ void qk_tile(const bf16x8 (&kf)[4], const LAS unsigned char* qh, f32x16& s) {
    const f32x16 z = {0.f, 0.f, 0.f, 0.f, 0.f, 0.f, 0.f, 0.f, 0.f, 0.f, 0.f, 0.f, 0.f, 0.f, 0.f, 0.f};
    s = __builtin_amdgcn_mfma_f32_32x32x16_bf16(kf[0], *(const LAS bf16x8*)qh, z, 0, 0, 0);
#pragma unroll
    for (int d0 = 1; d0 < 4; ++d0) s = __builtin_amdgcn_mfma_f32_32x32x16_bf16(kf[d0], *(const LAS bf16x8*)(qh + 32 * d0), s, 0, 0, 0);
}
__device__ __forceinline__ void q_rows_load(const bf16_t* proj, const ORows& R, int lane, u32x4 (&qv)[4]) {
#pragma unroll
    for (int i = 0; i < 4; ++i) { const int c = lane + 64 * i; qv[i] = *(const u32x4*)(proj + (orow_off(R, c >> 3) + (unsigned)((c & 7) * 8))); }
}
__device__ __forceinline__ void q_rows_stage(const u32x4 (&qv)[4], LAS unsigned char* qset, int lane) {
#pragma unroll
    for (int i = 0; i < 4; ++i) { const int c = lane + 64 * i; *(LAS u32x4*)(qset + (c >> 3) * QST_RS + (c & 7) * 16) = qv[i]; }
}
__device__ __forceinline__ float max3f(float a, float b, float c) { return fmaxf(fmaxf(a, b), c); }
__device__ __forceinline__ float max2f(float a, float b) { return fmaxf(a, b); }
typedef float f32x2 __attribute__((ext_vector_type(2)));
typedef __bf16 bf16x2_t __attribute__((ext_vector_type(2)));
__device__ __forceinline__ unsigned cvtpk_s(float lo, float hi) { f32x2 v = {lo, hi}; bf16x2_t b = __builtin_convertvector(v, bf16x2_t); return __builtin_bit_cast(unsigned, b); }
__device__ __forceinline__ void softmax_head(f32x16& s, int kb, int lq, int radius, bool full, int hi, HState& S) {
    if (!full) {
#pragma unroll
        for (int r = 0; r < 16; ++r) { const int lk = kb + 16 * (r >> 3) + 8 * hi + (r & 7); const int d = lk - lq;
            const bool valid = (unsigned)(d + radius) <= (unsigned)(2 * radius); s[r] = valid ? s[r] : -INFINITY; }
    }
    float t0 = max3f(s[0], s[1], s[2]), t1 = max3f(s[3], s[4], s[5]);
    t0 = max3f(t0, s[6], s[7]); t1 = max3f(t1, s[8], s[9]); t0 = max3f(t0, s[10], s[11]); t1 = max3f(t1, s[12], s[13]);
    float tmax = max3f(t0, s[14], s[15]); tmax = max2f(tmax, t1);
    { auto rr = __builtin_amdgcn_permlane32_swap(__float_as_uint(tmax), __float_as_uint(tmax), false, false); tmax = max2f(__uint_as_float(rr[0]), __uint_as_float(rr[1])); }
    if (__builtin_amdgcn_ballot_w64(tmax > S.m + 8.0f) != 0ull) {
        const float mn = max2f(S.m, tmax), alpha = __builtin_amdgcn_exp2f(S.m - mn); S.m = mn; S.l *= alpha;
#pragma unroll
        for (int dh = 0; dh < 2; ++dh)
#pragma unroll
            for (int r = 0; r < 16; ++r) S.o[dh][r] *= alpha;
    }
}
__device__ __forceinline__ void softmax_tail(f32x16& s, HState& S, u32x4 (&pw)[2]) {
    const float mn = S.m;
#pragma unroll
    for (int r = 0; r < 16; ++r) s[r] -= mn;
#pragma unroll
    for (int r = 0; r < 16; ++r) s[r] = __builtin_amdgcn_exp2f(s[r]);
    float p0 = s[0], p1 = s[1];
#pragma unroll
    for (int r = 2; r < 16; r += 2) { p0 += s[r]; p1 += s[r + 1]; }
    S.l += p0 + p1;
#pragma unroll
    for (int ks = 0; ks < 2; ++ks) { pw[ks].x = cvtpk_s(s[8 * ks + 0], s[8 * ks + 1]); pw[ks].y = cvtpk_s(s[8 * ks + 2], s[8 * ks + 3]); pw[ks].z = cvtpk_s(s[8 * ks + 4], s[8 * ks + 5]); pw[ks].w = cvtpk_s(s[8 * ks + 6], s[8 * ks + 7]); }
}
__device__ __forceinline__ void softmax_tile(f32x16& s, int kb, int lq, int radius, bool full, int hi, HState& S, u32x4 (&pw)[2]) { softmax_head(s, kb, lq, radius, full, hi, S); softmax_tail(s, S, pw); }
#define MFMA_VALU_INTERLEAVE() do { _Pragma("unroll") for (int g_ = 0; g_ < 4; ++g_) { __builtin_amdgcn_sched_group_barrier(0x008, 1, 0); __builtin_amdgcn_sched_group_barrier(0x002, 14, 0); } } while (0)
#ifndef XTRA_MFMA
#define XTRA_MFMA 0
#endif
__device__ __forceinline__ void pv_tile(const bf16x8 (&vf)[2][2], const u32x4 (&pw)[2], HState& S) {
#pragma unroll
    for (int ks = 0; ks < 2; ++ks)
#pragma unroll
        for (int dh = 0; dh < 2; ++dh) S.o[dh] = __builtin_amdgcn_mfma_f32_32x32x16_bf16(vf[ks][dh], __builtin_bit_cast(bf16x8, pw[ks]), S.o[dh], 0, 0, 0);
    if (XTRA_MFMA) {
        u32x4 zz = {0u, 0u, 0u, 0u}; asm volatile("" : "+v"(zz));
#pragma unroll
        for (int k = 0; k < XTRA_MFMA; ++k) S.o[k & 1] = __builtin_amdgcn_mfma_f32_32x32x16_bf16(vf[0][k & 1], __builtin_bit_cast(bf16x8, zz), S.o[k & 1], 0, 0, 0);
    }
}
struct QSet { int lq, lqmin, lqmax; };
template <int NH>
__device__ __forceinline__ void tile_all(const KVFrag& f, const LAS unsigned char* ql, LAS unsigned char* vst, int lane, int hi, int kb, int radius, const QSet& qa, const QSet& qb, HState& A, HState& B) {
    bf16x8 vf[2][2], kf[4]; stage_v(f, vst, lane, hi, vf, kf);
    f32x16 sa; u32x4 pwa[2];
    qk_tile(kf, ql, sa);
    if (NH == 1) {
        softmax_tile(sa, kb, qa.lq, radius, (kb >= qa.lqmax - radius) && (kb + 31 <= qa.lqmin + radius), hi, A, pwa);
        pv_tile(vf, pwa, A);
    } else {
        f32x16 sb; u32x4 pwb[2];
        softmax_head(sa, kb, qa.lq, radius, (kb >= qa.lqmax - radius) && (kb + 31 <= qa.lqmin + radius), hi, A);
        __builtin_amdgcn_sched_barrier(0);
        qk_tile(kf, ql + QST_SET, sb);
        softmax_tail(sa, A, pwa);
        MFMA_VALU_INTERLEAVE();
        __builtin_amdgcn_sched_barrier(0);
        softmax_head(sb, kb, qb.lq, radius, (kb >= qb.lqmax - radius) && (kb + 31 <= qb.lqmin + radius), hi, B);
        __builtin_amdgcn_sched_barrier(0);
        pv_tile(vf, pwa, A);
        softmax_tail(sb, B, pwb);
        MFMA_VALU_INTERLEAVE();
        __builtin_amdgcn_sched_barrier(0);
        pv_tile(vf, pwb, B);
    }
}
template <int NH>
__device__ __forceinline__ void attn_pass(const LAS unsigned char* ql, LAS unsigned char* vst, int lane, const bf16_t* K0, const bf16_t* V0, int mode, int rsel, int L, int kb0, int nt, int radius,
                                          const QSet& qa, const QSet& qb, HState& A, HState& B) {
    const int lane31 = lane & 31, hi = lane >> 5;
    const int jsw = (lane31 & 0x13) | ((lane31 & 4) << 1) | ((lane31 & 8) >> 1);
    const int ilo = kb0 < 0 ? ((-kb0) >> 5) : 0, ihi = min(nt, (L - kb0) >> 5);
    if (ilo >= ihi) return;
    KVFrag fa, fb;
    load_frags(fa, K0, V0, kb0 + 32 * ilo, mode, rsel, lane);
    int i = ilo;
    for (; i + 1 < ihi; i += 2) {
        const int kb = kb0 + 32 * i;
        __builtin_amdgcn_sched_barrier(0);
        load_frags(fb, K0, V0, kb + 32, mode, rsel, lane);
        tile_all<NH>(fa, ql, vst, lane, hi, kb, radius, qa, qb, A, B);
        __builtin_amdgcn_sched_barrier(0);
        load_frags(fa, K0, V0, kb0 + 32 * min(i + 2, ihi - 1), mode, rsel, lane);
        tile_all<NH>(fb, ql, vst, lane, hi, kb + 32, radius, qa, qb, A, B);
    }
    __builtin_amdgcn_sched_barrier(0);
    if (i < ihi) tile_all<NH>(fa, ql, vst, lane, hi, kb0 + 32 * i, radius, qa, qb, A, B);
}
constexpr int OST_RS = 144;
__device__ __forceinline__ void orows_put(const f32x16 (&o)[2], float sc, LAS unsigned char* stg, int lane) {
    const int q = lane & 31, hi = lane >> 5;
#pragma unroll
    for (int dh = 0; dh < 2; ++dh)
#pragma unroll
        for (int g = 0; g < 4; ++g) { u32x2 w; w.x = pk2(o[dh][4 * g] * sc, o[dh][4 * g + 1] * sc); w.y = pk2(o[dh][4 * g + 2] * sc, o[dh][4 * g + 3] * sc);
            *(LAS u32x2*)(stg + q * OST_RS + (32 * dh + 8 * g + 4 * hi) * 2) = w; }
}
__device__ __forceinline__ void orows_store(LAS unsigned char* stg, bf16_t* mix, const ORows& R, int lane) {
#pragma unroll
    for (int i = 0; i < 4; ++i) { const int c = lane + 64 * i, rr = c >> 3, pc = c & 7;
        const u32x4 v = *(const LAS u32x4*)(stg + rr * OST_RS + pc * 16);
        *(u32x4*)(mix + (orow_off(R, rr) + (unsigned)(pc * 8))) = v; }
}
__device__ __forceinline__ void attn_store(const HState& S, bf16_t* mix, const ORows& R, LAS unsigned char* stg, int lane) {
    float l = pg8::sum_x32(S.l);
    orows_put(S.o, 1.0f / l, stg, lane);
    orows_store(stg, mix, R, lane);
}
__device__ __forceinline__ void attn_store_lse(const HState& S, bf16_t* mix, const ORows& R, LAS unsigned char* stg, float* lsep, int lane) {
    float l = pg8::sum_x32(S.l);
    orows_put(S.o, 1.0f / l, stg, lane);
    orows_store(stg, mix, R, lane);
    if ((lane >> 5) == 0) *lsep = S.m + __builtin_amdgcn_logf(l);
}
__device__ __forceinline__ void attn_store_merge(const HState& S, bf16_t* mix, const ORows& R, LAS unsigned char* stg, const float* lsep, int lane) {
    const int q = lane & 31, hi = lane >> 5;
    u32x4 xr[4];
#pragma unroll
    for (int i = 0; i < 4; ++i) { const int c = lane + 64 * i; xr[i] = *(const u32x4*)(mix + (orow_off(R, c >> 3) + (unsigned)((c & 7) * 8))); }
    float l = pg8::sum_x32(S.l);
    const float lx = *lsep, M = fmaxf(S.m, lx), wy = __builtin_amdgcn_exp2f(S.m - M), wx = __builtin_amdgcn_exp2f(lx - M);
    const float inv = 1.0f / (wy * l + wx), ay = wy * inv, ax = wx * inv;
#pragma unroll
    for (int i = 0; i < 4; ++i) { const int c = lane + 64 * i; *(LAS u32x4*)(stg + (c >> 3) * OST_RS + (c & 7) * 16) = xr[i]; }
#pragma unroll
    for (int dh = 0; dh < 2; ++dh)
#pragma unroll
        for (int g = 0; g < 4; ++g) { LAS u32x2* slot = (LAS u32x2*)(stg + q * OST_RS + (32 * dh + 8 * g + 4 * hi) * 2); const u32x2 old = *slot;
            u32x2 w; w.x = pk2(S.o[dh][4 * g] * ay + __uint_as_float(old.x << 16) * ax, S.o[dh][4 * g + 1] * ay + __uint_as_float(old.x & 0xffff0000u) * ax);
            w.y = pk2(S.o[dh][4 * g + 2] * ay + __uint_as_float(old.y << 16) * ax, S.o[dh][4 * g + 3] * ay + __uint_as_float(old.y & 0xffff0000u) * ax);
            *slot = w; }
    orows_store(stg, mix, R, lane);
}
__device__ __forceinline__ void hstate_init(HState& S, float m, float l) {
#pragma unroll
    for (int r = 0; r < 16; ++r) { S.o[0][r] = 0.f; S.o[1][r] = 0.f; }
    S.m = m; S.l = l;
}

__device__ __forceinline__ void attn_even_unit(int uid, const bf16_t* proj, const bf16_t* kd, const bf16_t* vd, bf16_t* mix, const float* sink, int lane, LAS bf16x8* qlds  , LAS unsigned char* vst) {
    asm volatile("v_mbcnt_lo_u32_b32 %0, -1, 0\n\tv_mbcnt_hi_u32_b32 %0, -1, %0" : "=v"(lane));
    const int qt = uid & 127, kvh = (uid >> 7) & 1, b = uid >> 8;
    const int q0 = qt * 32;
    const bf16_t* K0 = kd + (size_t)(b * 2 + kvh) * (4096 * 64);
    const bf16_t* V0 = vd + (size_t)(b * 2 + kvh) * (4096 * 64);
    for (int hp = 0; hp < 2; ++hp) {
        const int h0 = kvh * 4 + hp * 2;
        asm volatile("v_mbcnt_lo_u32_b32 %0, -1, 0\n\tv_mbcnt_hi_u32_b32 %0, -1, %0" : "=v"(lane));
        const int lane31 = lane & 31, hi = lane >> 5, t = q0 + lane31; const QSet qs{t, q0, q0 + 31};
        { u32x4 qa_[4], qb_[4];
          const ORows Ra{(unsigned)(b * SEQ + q0), 1u, 31u, 5u, 1280u, (unsigned)(h0 * 64)}, Rb{(unsigned)(b * SEQ + q0), 1u, 31u, 5u, 1280u, (unsigned)((h0 + 1) * 64)};
          q_rows_load(proj, Ra, lane, qa_); q_rows_load(proj, Rb, lane, qb_);
          q_rows_stage(qa_, (LAS unsigned char*)qlds, lane); q_rows_stage(qb_, (LAS unsigned char*)qlds + QST_SET, lane); }
        HState A, B;
        hstate_init(A, sink[h0] * 1.4426950408889634f, (hi == 0) ? 1.f : 0.f); hstate_init(B, sink[h0 + 1] * 1.4426950408889634f, (hi == 0) ? 1.f : 0.f);
        attn_pass<2>((const LAS unsigned char*)qlds + lane31 * QST_RS + 16 * hi, vst, lane, K0, V0, 0, 0, SEQ, q0 - 128, 9, 128, qs, qs, A, B);
        asm volatile("v_mbcnt_lo_u32_b32 %0, -1, 0\n\tv_mbcnt_hi_u32_b32 %0, -1, %0" : "=v"(lane));
        { const ORows R{(unsigned)(b * SEQ + q0), 1u, 31u, 5u, 1024u, (unsigned)(h0 * 64)}; attn_store(A, mix, R, vst, lane); }
        { const ORows R{(unsigned)(b * SEQ + q0), 1u, 31u, 5u, 1024u, (unsigned)((h0 + 1) * 64)}; attn_store(B, mix, R, vst, lane); }
    }
}
__device__ __forceinline__ void attn_x_unit(int uid, const bf16_t* proj, const bf16_t* kd, const bf16_t* vd, bf16_t* mix, float* lse, int lane, LAS bf16x8* qlds, LAS unsigned char* vst) {
    asm volatile("v_mbcnt_lo_u32_b32 %0, -1, 0\n\tv_mbcnt_hi_u32_b32 %0, -1, %0" : "=v"(lane));
    const int qt = uid & 127, kvh = (uid >> 7) & 3, b = uid >> 9, lane31 = lane & 31, hi = lane >> 5;
    const int q0 = qt * 32, t = q0 + lane31; const size_t row = (size_t)b * SEQ + t;
    const bf16_t* K0 = kd + (size_t)(b * 4 + kvh) * (4096 * 64);
    const bf16_t* V0 = vd + (size_t)(b * 4 + kvh) * (4096 * 64);
    const QSet qs{t, q0, q0 + 31};
    { u32x4 qa_[4], qb_[4];
      const ORows Ra{(unsigned)(b * SEQ + q0), 1u, 31u, 5u, 2048u, (unsigned)((kvh * 2) * 64)}, Rb{(unsigned)(b * SEQ + q0), 1u, 31u, 5u, 2048u, (unsigned)((kvh * 2 + 1) * 64)};
      q_rows_load(proj, Ra, lane, qa_); q_rows_load(proj, Rb, lane, qb_);
      q_rows_stage(qa_, (LAS unsigned char*)qlds, lane); q_rows_stage(qb_, (LAS unsigned char*)qlds + QST_SET, lane); }
    HState A, B; hstate_init(A, -1e30f, 0.f); hstate_init(B, -1e30f, 0.f);
    attn_pass<2>((const LAS unsigned char*)qlds + lane31 * QST_RS + 16 * hi, vst, lane, K0, V0, 2, 0, SEQ, q0 - 64, 5, 64, qs, qs, A, B);
    { const ORows R{(unsigned)(b * SEQ + q0), 1u, 31u, 5u, 512u, (unsigned)((kvh * 2) * 64)}; attn_store_lse(A, mix, R, vst, lse + (size_t)(kvh * 2) * NTOK + row, lane); }
    { const ORows R{(unsigned)(b * SEQ + q0), 1u, 31u, 5u, 512u, (unsigned)((kvh * 2 + 1) * 64)}; attn_store_lse(B, mix, R, vst, lse + (size_t)(kvh * 2 + 1) * NTOK + row, lane); }
}
__device__ __forceinline__ void attn_odd_unit(int uid, const bf16_t* proj, const bf16_t* kd, const bf16_t* vd, bf16_t* mix, const float* lse, int lane, LAS bf16x8* qlds, LAS unsigned char* vst) {
    asm volatile("v_mbcnt_lo_u32_b32 %0, -1, 0\n\tv_mbcnt_hi_u32_b32 %0, -1, %0" : "=v"(lane));
    const int rp = uid & 7, lt = (uid >> 3) & 15, kvh = (uid >> 7) & 3, b = uid >> 9, lane31 = lane & 31, hi = lane >> 5;
    const int rA = (rp & 3) + 8 * (rp >> 2), rB = rA + 4;
    const int j = lane31 >> 4, a = lane31 & 15, l0 = lt * 16, tA = rA + 16 * (l0 + a); const size_t rowA = (size_t)b * SEQ + tA, rowB = rowA + 4;
    HState A, B; hstate_init(A, -1e30f, 0.f); hstate_init(B, -1e30f, 0.f);
    const size_t LAY = (size_t)16 * 256 * 4096;
    const size_t bk = (size_t)(b * 4 + kvh) * (4096 * 64);
#pragma unroll
    for (int g = 1; g < 3; ++g) {
        const int D = (g == 0) ? 1 : (g == 1 ? 4 : 16), s = 16 / D, L = SEQ / D, nt = (g == 0) ? 12 : (g == 1 ? 6 : 5);
        const int head = g * 8 + kvh * 2 + j;
        { u32x4 qa_[4], qb_[4];
          const ORows Ra{(unsigned)(b * SEQ + rA + 16 * l0), 16u, 15u, 4u, 2048u, (unsigned)((g * 8 + kvh * 2) * 64)}, Rb{(unsigned)(b * SEQ + rB + 16 * l0), 16u, 15u, 4u, 2048u, (unsigned)((g * 8 + kvh * 2) * 64)};
          q_rows_load(proj, Ra, lane, qa_); q_rows_load(proj, Rb, lane, qb_);
          q_rows_stage(qa_, (LAS unsigned char*)qlds, lane); q_rows_stage(qb_, (LAS unsigned char*)qlds + QST_SET, lane); }
        const int cA = rA / D, cB = rB / D;
        const QSet qa{cA + s * (l0 + a), cA + s * l0, cA + s * (l0 + 15)}, qb{cB + s * (l0 + a), cB + s * l0, cB + s * (l0 + 15)};
        const int kb0 = (s * l0 - 64) & ~31;
        if (g < 2) {
            attn_pass<2>((const LAS unsigned char*)qlds + lane31 * QST_RS + 16 * hi, vst, lane, kd + bk, vd + bk, 1, rA & 3, L, kb0, nt, 64, qa, qb, A, B);
        } else {
            attn_pass<1>((const LAS unsigned char*)qlds + lane31 * QST_RS + 16 * hi, vst, lane, kd + bk + (size_t)(rA * L) * 64, vd + bk + (size_t)(rA * L) * 64, 0, 0, L, kb0, nt, 64, qa, qa, A, A);
            attn_pass<1>((const LAS unsigned char*)qlds + lane31 * QST_RS + 16 * hi + QST_SET, vst, lane, kd + bk + (size_t)(rB * L) * 64, vd + bk + (size_t)(rB * L) * 64, 0, 0, L, kb0, nt, 64, qb, qb, B, B);
        }
    }
    { const ORows R{(unsigned)(b * SEQ + rA + 16 * l0), 16u, 15u, 4u, 512u, (unsigned)((kvh * 2) * 64)}; attn_store_merge(A, mix, R, vst, lse + (size_t)(kvh * 2 + j) * NTOK + rowA, lane); }
    { const ORows R{(unsigned)(b * SEQ + rB + 16 * l0), 16u, 15u, 4u, 512u, (unsigned)((kvh * 2) * 64)}; attn_store_merge(B, mix, R, vst, lse + (size_t)(kvh * 2 + j) * NTOK + rowB, lane); }
}
__device__ __forceinline__ void bf8_unpack(const u32x4 v, float (&f)[8]) {
#pragma unroll
    for (int i = 0; i < 4; ++i) { f[2 * i] = __uint_as_float(v[i] << 16); f[2 * i + 1] = __uint_as_float(v[i] & 0xffff0000u); }
}
__device__ __forceinline__ void pool_rows32(int row0, const bf16_t* proj, bf16_t* mix, int lane) {
    const int t0 = row0 & 4095, w2 = 1 << (lane >> 4);
    const bf16_t* base = proj + (size_t)(row0 - t0) * 1280 + 768 + 8 * lane;
    float S[8];
#pragma unroll
    for (int i = 0; i < 8; ++i) S[i] = 0.f;
    {
        u32x4 v[16];
#pragma unroll
        for (int k = 0; k < 16; ++k) { const int off = k - 8, tt = t0 + off; const bool ok = (off >= -w2) && (off < w2) && (tt >= 0) && (tt < SEQ);
            v[k] = (u32x4){0u, 0u, 0u, 0u}; if (ok) v[k] = *(const u32x4*)(base + (unsigned)tt * 1280u); }
#pragma unroll
        for (int k = 0; k < 16; ++k) { float f[8]; bf8_unpack(v[k], f);
#pragma unroll
            for (int i = 0; i < 8; ++i) S[i] += f[i]; }
    }
#pragma unroll 1
    for (int rb = 0; rb < 32; rb += 8) {
        u32x4 ve[8], vl[8], vc[8];
#pragma unroll
        for (int r = 0; r < 8; ++r) { const int t = t0 + rb + r, te = t + w2, tl = t - w2;
            vc[r] = *(const u32x4*)(base + (unsigned)t * 1280u);
            ve[r] = (u32x4){0u, 0u, 0u, 0u}; if (te < SEQ) ve[r] = *(const u32x4*)(base + (unsigned)te * 1280u);
            vl[r] = (u32x4){0u, 0u, 0u, 0u}; if (tl >= 0) vl[r] = *(const u32x4*)(base + (unsigned)tl * 1280u); }
#pragma unroll
        for (int r = 0; r < 8; ++r) { const int t = t0 + rb + r, lo = max(t - w2, 0), hi = min(t + w2, SEQ);
            const float inv = 1.0f / (float)(hi - lo);
            float c[8], d[8]; bf8_unpack(vc[r], c);
#pragma unroll
            for (int i = 0; i < 8; ++i) d[i] = S[i] * inv - c[i];
            u32x4 w; w.x = pk2(d[0], d[1]); w.y = pk2(d[2], d[3]); w.z = pk2(d[4], d[5]); w.w = pk2(d[6], d[7]);
            *(u32x4*)(mix + (size_t)(row0 + rb + r) * 1024 + 512 + 8 * lane) = w;
            float e[8], l[8]; bf8_unpack(ve[r], e); bf8_unpack(vl[r], l);
#pragma unroll
            for (int i = 0; i < 8; ++i) S[i] += e[i] - l[i]; }
    }
}

__global__ void __launch_bounds__(NTHREADS, 2) fwd_megakernel(Params p) {
    extern __shared__ __attribute__((aligned(16))) unsigned char lds_raw[];
    cg::grid_group grid = cg::this_grid();
    LAS unsigned char* lds = (LAS unsigned char*)lds_raw;
    const int tid = threadIdx.x, lane = tid & 63, wave = __builtin_amdgcn_readfirstlane(tid >> 6);
    const int G = gridDim.x, bx = blockIdx.x;
    const int gw = bx * NWAVES + wave, NGW = G * NWAVES;
    const int vb = (G % 8 == 0) ? (bx % 8) * (G / 8) + bx / 8 : bx;
    unsigned char* ws = p.ws;
    bf16_t* XB = (bf16_t*)(ws + WS_XB); bf16_t* PROJ = (bf16_t*)(ws + WS_PROJ); bf16_t* VT = (bf16_t*)(ws + WS_VT); bf16_t* MIX = (bf16_t*)(ws + WS_MIX); bf16_t* KD = (bf16_t*)(ws + WS_KD); bf16_t* UB = (bf16_t*)(ws + WS_U);
    float* PART = (float*)(ws + WS_PART); float* LSE = (float*)(ws + WS_LSE); float* CS = (float*)(ws + WS_CS); float* WF = (float*)(ws + WS_WF);

    volatile LAS unsigned* MISC = (volatile LAS unsigned*)(lds + MISC_OFF);
    if (tid < 4) MISC[tid] = 0u;
    unsigned* BAR = (unsigned*)(ws + WS_BAR);
    if (bx == 0) for (int i = tid; i < XCD_BAR_WORDS; i += NTHREADS) BAR[i] = 0u;
    __syncthreads();
#ifndef REP_PRO
#define REP_PRO 1
#endif
    for (int rep_p = 0; rep_p < REP_PRO; ++rep_p)
    {
        const int gt = bx * NTHREADS + tid, NT = G * NTHREADS;
        for (int u = gw; u < 2048; u += NGW) {
            const int nb = u & 15, k8 = (u >> 4) & 15, g = (u >> 8) & 3, e = u >> 10, n = nb * 64 + lane, k0 = k8 * 8;
            const float* wp = p.w_pool + ((size_t)(e * 4 + g) * 128 + k0) * 128; const float* sc = p.pool_scale + e * 512 + g * 128;
            const float* wo = p.w_out_even + ((size_t)e * 1024 + 512 + g * 128) * 1024 + n;
            float acc[8];
#pragma unroll
            for (int i = 0; i < 8; ++i) acc[i] = 0.f;
#pragma unroll 16
            for (int jj = 0; jj < 128; ++jj) { const float w = wo[(size_t)jj * 1024] * sc[jj];
#pragma unroll
                for (int i = 0; i < 8; ++i) acc[i] += wp[i * 128 + jj] * w; }
            u32x4 o; o.x = pk2(acc[0], acc[1]); o.y = pk2(acc[2], acc[3]); o.z = pk2(acc[4], acc[5]); o.w = pk2(acc[6], acc[7]);
            *(u32x4*)((bf16_t*)(ws + WS_WOUT_E) + (size_t)e * 1024 * 1024 + (size_t)n * 1024 + 512 + g * 128 + k0) = o;
        }
        for (int idx = gt; idx < SEQ * 8; idx += NT) {
            const int i = idx & 7, pos = idx >> 3;
            const float inv = (i == 0) ? 1.0f : (i == 1) ? 0.1939227432012558f : (i == 2) ? 0.03760603070259094f : (i == 3) ? 0.007292664609849453f : (i == 4) ? 0.0014142135623842478f : (i == 5) ? 0.00027424818836152554f : (i == 6) ? 5.3182957344688475e-05f : 1.0313385246263351e-05f;
            float c, s; sincos_d((float)pos * inv, c, s);
            CS[pos * 16 + i] = c; CS[pos * 16 + 8 + i] = s;
        }
        {
            LAS float* scr = (LAS float*)(lds + wave * 16384);
            int itbase = 0;
            for (int jb = 0; jb < NJOBS; ++jb) {
                const Job J = get_job(p, jb); const int nitems = (J.Kr / 64) * (J.N / 32);
                const int first = (gw - (itbase % NGW) + NGW) % NGW;
                for (int it = first; it < nitems; it += NGW) transpose_item(J.W, J.g, J.N, J.WT, J.ldk, J.koff, scr, it, lane);
                itbase += nitems;
            }
        }
        for (int r0 = gw * 4; r0 < NTOK; r0 += NGW * 4) {
            f32x4 v[4][4];
#pragma unroll
            for (int q = 0; q < 4; ++q) { const f32x4* xr = (const f32x4*)(p.x + (size_t)(r0 + q) * DM) + lane;
#pragma unroll
                for (int jj = 0; jj < 4; ++jj) v[q][jj] = xr[64 * jj]; }
            float ssq[4];
#pragma unroll
            for (int q = 0; q < 4; ++q) { float ss = 0.f; unsigned long long* o8 = (unsigned long long*)(XB + (size_t)(r0 + q) * DM) + lane;
#pragma unroll
                for (int jj = 0; jj < 4; ++jj) { ss += (v[q][jj][0] * v[q][jj][0] + v[q][jj][1] * v[q][jj][1]) + (v[q][jj][2] * v[q][jj][2] + v[q][jj][3] * v[q][jj][3]);
                    o8[64 * jj] = (unsigned long long)pk2(v[q][jj][0], v[q][jj][1]) | ((unsigned long long)pk2(v[q][jj][2], v[q][jj][3]) << 32); }
                ssq[q] = wave_sum(ss); }
            { const int sl = lane >= 60 ? 0 : 1 + (lane >> 2), qq = lane >= 60 ? lane - 60 : (lane & 3);
              const float val = lane >= 60 ? (qq == 0 ? ssq[0] : qq == 1 ? ssq[1] : qq == 2 ? ssq[2] : ssq[3]) : 0.f;
              PART[(size_t)sl * NTOK + r0 + qq] = val; }
        }
    }
    grid.sync();
    const XcdBarrier xbar = xcd_barrier_post(BAR, MISC, wave);
#define GRID_BAR() xcd_barrier(xbar, wave)
#ifndef XBAR_EXTRA
#define XBAR_EXTRA 0
#endif
    for (int xs = 0; xs < XBAR_EXTRA; ++xs) GRID_BAR();

    for (int layer = 0; layer < 4; ++layer) {
        const int odd = layer & 1, li = layer >> 1;
        {
            const int N = odd ? 2048 : 1280;
            const bf16_t* Wt = odd ? (const bf16_t*)(ws + WS_WIN_O) + (size_t)li * 2048 * 1024 : (const bf16_t*)(ws + WS_WIN_E) + (size_t)li * 1280 * 1024;
            pg8::Gemm g{XB, Wt, NTOK, N, 1024}; pg8::StaticOrder S; S.init(NTOK, N, G, bx);
            pg8::EpiProj E{PROJ, N, PART, CS, VT, KD, odd};
#ifndef REP_IN
#define REP_IN 1
#endif
            for (int rep = 0; rep < REP_IN; ++rep)
            pg8::gemm_phase<pg8::EpiProj, pg8::StaticOrder, true, true>(lds, g, S, E, wave);
        }
        GRID_BAR();
#ifndef REP_ATTN_E
#define REP_ATTN_E 1
#endif
#ifndef REP_ATTN_O
#define REP_ATTN_O 1
#endif
        for (int rep = 0; rep < (odd ? REP_ATTN_O : REP_ATTN_E); ++rep) {
        int lane_o; asm volatile("v_mbcnt_lo_u32_b32 %0, -1, 0\n\tv_mbcnt_hi_u32_b32 %0, -1, %0" : "=v"(lane_o)); const int gwv = vb * NWAVES + wave;
        if (wave >= 4) __builtin_amdgcn_s_setprio(1);
        if (odd) {
#ifndef REP_X
#define REP_X 1
#endif
            for (int rq = 0; rq < REP_X; ++rq)
            for (int uid = gwv; uid < 8192; uid += NGW) attn_x_unit(uid, PROJ, KD, VT, MIX, LSE, lane_o, (LAS bf16x8*)(lds + wave * WAVE_LDS), lds + wave * WAVE_LDS + 2 * QST_SET);
            __builtin_amdgcn_s_setprio(0);
            GRID_BAR();
            if (wave >= 4) __builtin_amdgcn_s_setprio(1);
            int lane_y; asm volatile("v_mbcnt_lo_u32_b32 %0, -1, 0\n\tv_mbcnt_hi_u32_b32 %0, -1, %0" : "=v"(lane_y));
            for (int uid = gwv; uid < 8192; uid += NGW) attn_odd_unit(uid, PROJ, KD, VT, MIX, LSE, lane_y, (LAS bf16x8*)(lds + wave * WAVE_LDS), lds + wave * WAVE_LDS + 2 * QST_SET);
        } else {
#ifndef REP_EATT
#define REP_EATT 1
#endif
#ifndef REP_POOL
#define REP_POOL 1
#endif
            for (int rq = 0; rq < REP_EATT; ++rq)
            for (int uid = gwv; uid < 4096; uid += NGW) attn_even_unit(uid, PROJ, KD, VT, MIX, p.sink + li * 8, lane_o, (LAS bf16x8*)(lds + wave * WAVE_LDS), lds + wave * WAVE_LDS + 2 * QST_SET);
            int lane_p; asm volatile("v_mbcnt_lo_u32_b32 %0, -1, 0\n\tv_mbcnt_hi_u32_b32 %0, -1, %0" : "=v"(lane_p));
            for (int rq = 0; rq < REP_POOL; ++rq)
            for (int r0 = gwv * 32; r0 < NTOK; r0 += NGW * 32) pool_rows32(r0, PROJ, MIX, lane_p);
        }
        __builtin_amdgcn_s_setprio(0);
        }
        GRID_BAR();
        {
            const int K = odd ? 512 : 1024;
            const bf16_t* Wt = odd ? (const bf16_t*)(ws + WS_WOUT_O) + (size_t)li * 1024 * 512 : (const bf16_t*)(ws + WS_WOUT_E) + (size_t)li * 1024 * 1024;
            pg8::Gemm g{MIX, Wt, NTOK, 1024, K}; pg8::StaticOrder S; S.init(NTOK, 1024, G, bx);
#ifndef REP_OUT
#define REP_OUT 0
#endif
            for (int rq = 0; rq < REP_OUT; ++rq) {
                pg8::EpiRes E2{XB, PART, (bf16_t*)(ws + 800 * MiB), (float*)(ws + 930 * MiB)};
                pg8::gemm_phase<pg8::EpiRes, pg8::StaticOrder, true, true>(lds, g, S, E2, wave);
            }
            pg8::EpiRes E{XB, PART, XB, PART};
            pg8::gemm_phase<pg8::EpiRes, pg8::StaticOrder, true, true>(lds, g, S, E, wave);
        }
        GRID_BAR();
        {
            pg8::Gemm g{XB, (const bf16_t*)(ws + WS_WUP) + (size_t)layer * 4096 * 1024, NTOK, 4096, 1024}; pg8::StaticOrder S; S.init(NTOK, 4096, G, bx);
            pg8::EpiUp E{UB, PART};
#ifndef REP_UP
#define REP_UP 1
#endif
            for (int rep = 0; rep < REP_UP; ++rep)
            pg8::gemm_phase<pg8::EpiUp, pg8::StaticOrder, true, true>(lds, g, S, E, wave);
        }
        GRID_BAR();
        {
            pg8::Gemm g{UB, (const bf16_t*)(ws + WS_WDN) + (size_t)layer * 1024 * 4096, NTOK, 1024, 4096}; pg8::StaticOrder S; S.init(NTOK, 1024, G, bx);
#ifndef REP_DOWN
#define REP_DOWN 0
#endif
            for (int rq = 0; rq < REP_DOWN; ++rq) {
                pg8::EpiRes E2{XB, PART, (bf16_t*)(ws + 800 * MiB), (float*)(ws + 930 * MiB)};
                pg8::gemm_phase<pg8::EpiRes, pg8::StaticOrder, true, true>(lds, g, S, E2, wave);
            }
            pg8::EpiRes E{XB, PART, XB, PART};
            pg8::gemm_phase<pg8::EpiRes, pg8::StaticOrder, true, true>(lds, g, S, E, wave);
        }
        GRID_BAR();
    }
#ifndef REP_FINAL
#define REP_FINAL 1
#endif
    for (int rep_f = 0; rep_f < REP_FINAL; ++rep_f) {
    int lane_f; asm volatile("v_mbcnt_lo_u32_b32 %0, -1, 0\n\tv_mbcnt_hi_u32_b32 %0, -1, %0" : "=v"(lane_f)); const int gw_f = gw;
    for (int r0 = gw_f * 4; r0 < NTOK; r0 += NGW * 4) {
        unsigned long long xw[4][4];
        float ps = PART[(size_t)(lane_f & 15) * NTOK + r0 + (lane_f >> 4)];
#pragma unroll
        for (int q = 0; q < 4; ++q) { const unsigned long long* xr = (const unsigned long long*)(XB + (size_t)(r0 + q) * DM) + lane_f;
#pragma unroll
            for (int jj = 0; jj < 4; ++jj) xw[q][jj] = xr[64 * jj]; }
        ps += __builtin_bit_cast(float, __builtin_amdgcn_mov_dpp(__builtin_bit_cast(int, ps), 0xB1, 0xF, 0xF, true));
        ps += __builtin_bit_cast(float, __builtin_amdgcn_mov_dpp(__builtin_bit_cast(int, ps), 0x4E, 0xF, 0xF, true));
        ps += __builtin_bit_cast(float, __builtin_amdgcn_mov_dpp(__builtin_bit_cast(int, ps), 0x124, 0xF, 0xF, true));
        ps += __builtin_bit_cast(float, __builtin_amdgcn_mov_dpp(__builtin_bit_cast(int, ps), 0x128, 0xF, 0xF, true));
        const f32x4* gr = (const f32x4*)p.norm_final + lane_f;
#pragma unroll
        for (int q = 0; q < 4; ++q) {
            const float s = __builtin_bit_cast(float, __builtin_amdgcn_readlane(__builtin_bit_cast(int, ps), 16 * q));
            const float rs = __builtin_amdgcn_rsqf(s * (1.0f / 1024.0f) + 1e-6f);
            f32x4* orow = (f32x4*)(p.out + (size_t)(r0 + q) * DM) + lane_f;
#pragma unroll
            for (int jj = 0; jj < 4; ++jj) { const unsigned long long w = xw[q][jj]; const unsigned lo = (unsigned)w, hi = (unsigned)(w >> 32); const f32x4 gg = gr[64 * jj];
                f32x4 v; v[0] = __uint_as_float(lo << 16); v[1] = __uint_as_float(lo & 0xffff0000u); v[2] = __uint_as_float(hi << 16); v[3] = __uint_as_float(hi & 0xffff0000u);
                __builtin_nontemporal_store(v * rs * gg, &orow[64 * jj]); }
        }
    }
    }
}

extern "C" void kernel_launch(void* const* d_in, const int* in_sizes, int n_in, void* d_out, int out_size, void* d_ws, size_t ws_size, hipStream_t stream) {
    static int grid_blocks = 0;
    if (grid_blocks == 0) {
        if (n_in != 13 || out_size != NTOK * DM || ws_size < WS_END) { fprintf(stderr, "kernel_launch: unexpected shapes (n_in %d out %d ws %zu)\n", n_in, out_size, ws_size); grid_blocks = -1; return; }
        int dev = 0, cus = 0, per_cu = 0;
        hipGetDevice(&dev); hipDeviceGetAttribute(&cus, hipDeviceAttributeMultiprocessorCount, dev);
        hipFuncSetAttribute((const void*)fwd_megakernel, hipFuncAttributeMaxDynamicSharedMemorySize, LDS_ALLOC);
        hipOccupancyMaxActiveBlocksPerMultiprocessor(&per_cu, (const void*)fwd_megakernel, NTHREADS, LDS_ALLOC);
        if (per_cu < 1) per_cu = 1;
        (void)hipGetLastError();
        grid_blocks = cus * per_cu;
    }
    if (grid_blocks < 0) return;
    Params p{};
    p.x = (const float*)d_in[0]; p.norm_mix = (const float*)d_in[1]; p.norm_mlp = (const float*)d_in[2]; p.norm_final = (const float*)d_in[3];
    p.w_in_even = (const float*)d_in[4]; p.w_out_even = (const float*)d_in[5]; p.sink = (const float*)d_in[6]; p.w_pool = (const float*)d_in[7]; p.pool_scale = (const float*)d_in[8];
    p.w_in_odd = (const float*)d_in[9]; p.w_out_odd = (const float*)d_in[10]; p.w_up = (const float*)d_in[11]; p.w_down = (const float*)d_in[12];
    p.out = (float*)d_out; p.ws = (unsigned char*)d_ws;
    void* args[] = {&p};
    hipError_t e = hipLaunchCooperativeKernel((const void*)fwd_megakernel, dim3(grid_blocks), dim3(NTHREADS), args, LDS_ALLOC, stream);
    if (e != hipSuccess) fprintf(stderr, "cooperative launch failed: %s (grid %d)\n", hipGetErrorString(e), grid_blocks);
}
```
